# Optimizing an MI355X kernel written in HIP

```python
import math
import jax, jax.numpy as jnp
from jax import lax
import numpy as np

D_MODEL = 1024
BATCH = 4
SEQ = 8192
DEPTH = 2

HEAD_DIM = 64
SWA_HEADS = 6
SWA_KV_HEADS = 2
SWA_GROUP = SWA_HEADS // SWA_KV_HEADS
SWA_WINDOW = 128
DIL_WINDOWS = (128, 512, 2048)
DIL_RATES = (1, 4, 16)
DIL_GROUPS = 3
DIL_HEADS_PER_GROUP = 2
DIL_HEADS = DIL_GROUPS * DIL_HEADS_PER_GROUP
MEM_HEADS = 4
MEM_LEN = 256
N_BUCKETS = 32
MAX_DISTANCE = 2048
SELF_HEADS = SWA_HEADS + DIL_HEADS
FFN_DIM = 2816
BLOCK = 128
N_BRANCH = 3
N_SANDWICH = 6
EPS = 1e-6

A_Q = SWA_HEADS * HEAD_DIM
A_KV = SWA_KV_HEADS * HEAD_DIM
B_W = DIL_HEADS * HEAD_DIM
C_W = MEM_HEADS * HEAD_DIM
P_IN = A_Q + 2 * A_KV + 3 * B_W + C_W

kernel_name = "hybrid_swa_dilated_memory_macaron_block"


def rms_norm(x, gain):
    x32 = x.astype(jnp.float32)
    y = x32 * lax.rsqrt(jnp.mean(x32 * x32, axis=-1, keepdims=True) + EPS)
    return (y * gain.astype(jnp.float32)).astype(x.dtype)


def swiglu(x, w_in, w_out):
    a, b = jnp.split(x @ w_in, 2, axis=-1)
    return (jax.nn.silu(a) * b) @ w_out


def t5_bucket(dist):
    max_exact = N_BUCKETS // 2
    d = jnp.maximum(dist, 1).astype(jnp.float32)
    large = max_exact + (jnp.log(d / max_exact) / math.log(MAX_DISTANCE / max_exact)
                         * (N_BUCKETS - max_exact)).astype(jnp.int32)
    large = jnp.minimum(large, N_BUCKETS - 1)
    return jnp.where(dist < max_exact, dist, large)


def band_distance():
    row = jnp.arange(BLOCK)[:, None]
    col = jnp.arange(2 * BLOCK)[None, :]
    return jnp.maximum(row + BLOCK - col, 0)


def band_mask(n_blocks, max_dist):
    row = jnp.arange(BLOCK)[:, None]
    col = jnp.arange(2 * BLOCK)[None, :]
    dist = row + BLOCK - col
    key_pos = jnp.arange(n_blocks)[:, None, None] * BLOCK - BLOCK + col[None]
    return ((dist >= 0) & (dist <= max_dist))[None] & (key_pos >= 0)


def key_windows(t):
    n, l = t.shape[:2]
    nb = l // BLOCK
    tp = jnp.pad(t, ((0, 0), (BLOCK, 0), (0, 0), (0, 0))).reshape(n, nb + 1, BLOCK, *t.shape[2:])
    return jnp.concatenate([tp[:, :-1], tp[:, 1:]], axis=2)


def banded_attention(q, k, v, bias, max_dist, sink):
    n, l, hk, g, hd = q.shape
    nb = l // BLOCK
    qb = q.reshape(n, nb, BLOCK, hk, g, hd)
    kw = key_windows(k)
    vw = key_windows(v)
    s = jnp.einsum('nbqhgd,nbkhd->nbhgqk', qb, kw,
                   preferred_element_type=jnp.float32) * (hd ** -0.5) + bias
    mask = band_mask(nb, max_dist)[None, :, None, None]
    s = jnp.where(mask, s, -jnp.inf)
    m = jnp.max(s, axis=-1)
    if sink is not None:
        sink32 = sink.astype(jnp.float32)[None, None, :, :, None]
        m = jnp.maximum(m, sink32)
    p = jnp.exp(s - m[..., None])
    denom = jnp.sum(p, axis=-1)
    if sink is not None:
        denom = denom + jnp.exp(sink32 - m)
    o = jnp.einsum('nbhgqk,nbkhd->nbqhgd', p, vw.astype(jnp.float32))
    o = o / jnp.moveaxis(denom, -1, 2)[..., None]
    lse = jnp.moveaxis(m + jnp.log(denom), -1, 2)
    return o.reshape(n, l, hk, g, hd), lse.reshape(n, l, hk, g)


def dilated_group(q, k, v, rate, window, bias):
    b, s, h, hd = q.shape
    l = s // rate
    lp = -(-l // BLOCK) * BLOCK

    def to_sub(t):
        t = t.reshape(b, l, rate, h, hd).transpose(0, 2, 1, 3, 4).reshape(b * rate, l, h, hd)
        return jnp.pad(t, ((0, 0), (0, lp - l), (0, 0), (0, 0)))

    o, lse = banded_attention(to_sub(q)[:, :, :, None], to_sub(k), to_sub(v),
                              bias, window // rate, None)
    o = o[:, :l, :, 0].reshape(b, rate, l, h, hd).transpose(0, 2, 1, 3, 4).reshape(b, s, h, hd)
    lse = lse[:, :l, :, 0].reshape(b, rate, l, h).transpose(0, 2, 1, 3).reshape(b, s, h)
    return o, lse


def mixing_sublayer(h, mem, bias_a, bias_b, mem_gain, w_in, sinks, w_mem_kv,
                    w_gate, b_gate, w_br_a, w_br_b, w_br_c, w_o):
    b, s, _ = h.shape
    z = h @ w_in
    qa, ka, va, qb, kb, vb, qc = jnp.split(
        z, np.cumsum([A_Q, A_KV, A_KV, B_W, B_W, B_W])[:].tolist(), axis=-1)

    oa, _ = banded_attention(
        qa.reshape(b, s, SWA_KV_HEADS, SWA_GROUP, HEAD_DIM),
        ka.reshape(b, s, SWA_KV_HEADS, HEAD_DIM),
        va.reshape(b, s, SWA_KV_HEADS, HEAD_DIM),
        bias_a, SWA_WINDOW - 1, sinks.reshape(SWA_KV_HEADS, SWA_GROUP))
    oa = oa.reshape(b, s, A_Q).astype(h.dtype)

    qb = qb.reshape(b, s, DIL_GROUPS, DIL_HEADS_PER_GROUP, HEAD_DIM)
    kb = kb.reshape(b, s, DIL_GROUPS, DIL_HEADS_PER_GROUP, HEAD_DIM)
    vb = vb.reshape(b, s, DIL_GROUPS, DIL_HEADS_PER_GROUP, HEAD_DIM)
    outs, lses = [], []
    for gi in range(DIL_GROUPS):
        o_g, l_g = dilated_group(qb[:, :, gi], kb[:, :, gi], vb[:, :, gi],
                                 DIL_RATES[gi], DIL_WINDOWS[gi], bias_b[gi])
        outs.append(o_g)
        lses.append(l_g)
    o_stack = jnp.stack(outs, axis=2)
    alpha = jax.nn.softmax(jnp.stack(lses, axis=2), axis=2)
    ob = (o_stack * alpha[..., None]).reshape(b, s, B_W).astype(h.dtype)

    mh = rms_norm(mem, mem_gain)
    kc, vc = jnp.split(mh @ w_mem_kv, 2, axis=-1)
    kc = kc.reshape(b, MEM_LEN, MEM_HEADS, HEAD_DIM)
    vc = vc.reshape(b, MEM_LEN, MEM_HEADS, HEAD_DIM)
    qc = qc.reshape(b, s, MEM_HEADS, HEAD_DIM)
    sc = jnp.einsum('bshd,bmhd->bhsm', qc, kc,
                    preferred_element_type=jnp.float32) * (HEAD_DIM ** -0.5)
    pc = jax.nn.softmax(sc, axis=-1)
    oc = jnp.einsum('bhsm,bmhd->bshd', pc, vc.astype(jnp.float32))
    oc = oc.reshape(b, s, C_W).astype(h.dtype)

    gates = jax.nn.sigmoid(h @ w_gate + b_gate.reshape(-1)).reshape(b, s, N_BRANCH, D_MODEL)
    merged = (gates[:, :, 0] * (oa @ w_br_a)
              + gates[:, :, 1] * (ob @ w_br_b)
              + gates[:, :, 2] * (oc @ w_br_c))
    return merged @ w_o


def setup_inputs(seed: int = 0) -> dict:
    key = jax.random.key(seed)
    ks = jax.random.split(key, 20)
    f32 = jnp.float32

    def nrm(k, shape, fan_in):
        return jax.random.normal(k, shape, f32) * (fan_in ** -0.5)

    return {
        "x": jax.random.normal(ks[0], (BATCH, SEQ, D_MODEL), f32),
        "mem": jax.random.normal(ks[1], (BATCH, MEM_LEN, D_MODEL), f32),
        "rel_bias": 0.5 * jax.random.normal(ks[2], (N_BUCKETS, SELF_HEADS), f32),
        "norm_gain": 1.0 + 0.05 * jax.random.normal(ks[3], (DEPTH, N_SANDWICH, D_MODEL), f32),
        "mem_norm_gain": 1.0 + 0.05 * jax.random.normal(ks[4], (DEPTH, D_MODEL), f32),
        "w_ffn1_in": nrm(ks[5], (DEPTH, D_MODEL, 2 * FFN_DIM), D_MODEL),
        "w_ffn1_out": nrm(ks[6], (DEPTH, FFN_DIM, D_MODEL), FFN_DIM),
        "w_in": nrm(ks[7], (DEPTH, D_MODEL, P_IN), D_MODEL),
        "sinks": 0.5 * jax.random.normal(ks[8], (DEPTH, SWA_HEADS), f32),
        "w_mem_kv": nrm(ks[9], (DEPTH, D_MODEL, 2 * C_W), D_MODEL),
        "w_gate": nrm(ks[10], (DEPTH, D_MODEL, N_BRANCH * D_MODEL), D_MODEL),
        "b_gate": 0.01 * jax.random.normal(ks[11], (DEPTH, N_BRANCH, D_MODEL), f32),
        "w_br_a": nrm(ks[12], (DEPTH, A_Q, D_MODEL), A_Q),
        "w_br_b": nrm(ks[13], (DEPTH, B_W, D_MODEL), B_W),
        "w_br_c": nrm(ks[14], (DEPTH, C_W, D_MODEL), C_W),
        "w_o": nrm(ks[15], (DEPTH, D_MODEL, D_MODEL), D_MODEL),
        "w_ffn2_in": nrm(ks[16], (DEPTH, D_MODEL, 2 * FFN_DIM), D_MODEL),
        "w_ffn2_out": nrm(ks[17], (DEPTH, FFN_DIM, D_MODEL), FFN_DIM),
    }


def reference(x, mem, rel_bias, norm_gain, mem_norm_gain, w_ffn1_in, w_ffn1_out,
              w_in, sinks, w_mem_kv, w_gate, b_gate, w_br_a, w_br_b, w_br_c, w_o,
              w_ffn2_in, w_ffn2_out):
    table = rel_bias.astype(jnp.float32)
    dist = band_distance()
    bias_a = table[t5_bucket(dist)][..., :SWA_HEADS].transpose(2, 0, 1)
    bias_a = bias_a.reshape(SWA_KV_HEADS, SWA_GROUP, BLOCK, 2 * BLOCK)
    bias_b = []
    for gi in range(DIL_GROUPS):
        h0 = SWA_HEADS + gi * DIL_HEADS_PER_GROUP
        bg = table[t5_bucket(dist * DIL_RATES[gi])][..., h0:h0 + DIL_HEADS_PER_GROUP]
        bias_b.append(bg.transpose(2, 0, 1)[:, None])

    for l in range(DEPTH):
        g = norm_gain[l]
        x = x + 0.5 * rms_norm(swiglu(rms_norm(x, g[0]), w_ffn1_in[l], w_ffn1_out[l]), g[1])
        y = mixing_sublayer(rms_norm(x, g[2]), mem, bias_a, bias_b, mem_norm_gain[l],
                            w_in[l], sinks[l], w_mem_kv[l], w_gate[l], b_gate[l],
                            w_br_a[l], w_br_b[l], w_br_c[l], w_o[l])
        x = x + rms_norm(y, g[3])
        x = x + 0.5 * rms_norm(swiglu(rms_norm(x, g[4]), w_ffn2_in[l], w_ffn2_out[l]), g[5])
    return x
```

```cpp
#include <hip/hip_runtime.h>
#include <hip/hip_cooperative_groups.h>
#include <cstdio>
#include <cstdint>
namespace cg = cooperative_groups;

#ifndef ONE_LAUNCH
#define ONE_LAUNCH 1
#endif

#define LAS __attribute__((address_space(3)))
#define GAS __attribute__((address_space(1)))

namespace pg8 {
#define PG8_LAS __attribute__((address_space(3)))
typedef unsigned short bf16_t;
typedef short bf16x8 __attribute__((ext_vector_type(8)));
typedef float f32x4 __attribute__((ext_vector_type(4)));
typedef unsigned u32x4 __attribute__((ext_vector_type(4)));
constexpr int BM = 256, BK = 64, HALF = 128, HTB = HALF * BK * 2  , STAGE_BYTES = 8 * HTB, NXCD = 8, WGM = 8;

__host__ __device__ __forceinline__ int lds_byte(int r, int c) { const int st = (r >> 4) * 2 + (c >> 5), rr = r & 15, cc = c & 31, ob = rr * 64 + cc * 2; return st * 1024 + (ob ^ (((ob >> 9) & 1) << 5)); }
__host__ __device__ __forceinline__ void stage_rc(int b, int& R, int& C) { const int st = b / 1024, sb = b % 1024, swz = sb ^ (((sb >> 9) & 1) << 5); R = (st >> 1) * 16 + swz / 64; C = (st & 1) * 32 + (swz % 64) / 2; }
__host__ __device__ __forceinline__ int perm32(int rho) { const int n = rho >> 4, i = rho & 15; return 8 * (i >> 2) + 4 * n + (i & 3); }

struct Unit { int pm, pn; };
struct Gemm { const bf16_t* A; const bf16_t* Bt; int M, N, K, lda; };

struct StaticOrder {
    int nM, nN, nwg, G, c;
    __host__ __device__ void init(int M, int N, int G_, int c_) { nM = M / BM; nN = N / BM; nwg = nM * nN; G = G_; c = c_; }
    __host__ __device__ bool next(int i, Unit& u) const {
        const long L = (long)i * G + c; if (L >= nwg) return false;
        int wgid = (int)L; { const int q = nwg / NXCD, r = nwg % NXCD, xcd = wgid % NXCD, off = wgid / NXCD; wgid = (xcd < r ? xcd * (q + 1) : r * (q + 1) + (xcd - r) * q) + off; }
        const int nig = WGM * nN, gid = wgid / nig, fm = gid * WGM, gsz = (nM - fm) < WGM ? (nM - fm) : WGM;
        u.pm = fm + ((wgid % nig) % gsz); u.pn = (wgid % nig) / gsz; return true;
    }
    __device__ __forceinline__ void a_ready(const Unit&) const {}
    __device__ __forceinline__ void done(const Unit&) const {}
};

typedef float f32x2_t __attribute__((ext_vector_type(2)));
typedef __bf16 bf16x2_t __attribute__((ext_vector_type(2)));
__device__ __forceinline__ unsigned cvt_pk_bf16(float lo, float hi) { f32x2_t v = {lo, hi}; bf16x2_t b = __builtin_convertvector(v, bf16x2_t); return __builtin_bit_cast(unsigned, b); }
__device__ __forceinline__ float bf_lo(unsigned w) { return __uint_as_float(w << 16); }
__device__ __forceinline__ float bf_hi(unsigned w) { return __uint_as_float(w & 0xffff0000u); }
__device__ __forceinline__ float sigmoid_f(float v) { return __builtin_amdgcn_rcpf(1.0f + __builtin_amdgcn_exp2f(-1.4426950408889634f * v)); }

template <int MODE> struct Epi {
    static constexpr bool PERM = true, AFTER_DRAIN = false;
    bf16_t* O; int ldc; const float* bias; const bf16_t* G; int ldg; int accum;
    __device__ __forceinline__ void operator()(const f32x4 (&acc)[2][2][4][2], const Unit& u, int wr, int wc, int fr, int fq) const {
        const int row0 = u.pm * BM + wr * 64 + fr;
        if constexpr (MODE == 1) {
            const int col0 = u.pn * HALF + wc * 32 + 8 * fq;
#pragma unroll
            for (int ai = 0; ai < 2; ++ai)
#pragma unroll
                for (int m = 0; m < 4; ++m) {
                    bf16_t* rowp = O + (size_t)(row0 + ai * HALF + m * 16) * ldc + col0;
                    float h[8];
#pragma unroll
                    for (int n = 0; n < 2; ++n)
#pragma unroll
                        for (int e = 0; e < 4; ++e) { const float a = acc[ai][0][m][n][e], b = acc[ai][1][m][n][e]; h[n * 4 + e] = a * sigmoid_f(a) * b; }
                    u32x4 w; w.x = cvt_pk_bf16(h[0], h[1]); w.y = cvt_pk_bf16(h[2], h[3]); w.z = cvt_pk_bf16(h[4], h[5]); w.w = cvt_pk_bf16(h[6], h[7]);
                    *(u32x4*)rowp = w;
                }
        } else {
            const int col0 = u.pn * BM + wc * 32 + 8 * fq;
#pragma unroll
            for (int bj = 0; bj < 2; ++bj) {
                const int c = col0 + bj * HALF;
                f32x4 bv0 = (f32x4){0.f, 0.f, 0.f, 0.f}, bv1 = bv0;
                if constexpr (MODE == 2) { bv0 = *(const f32x4*)(bias + c); bv1 = *(const f32x4*)(bias + c + 4); }
#pragma unroll
                for (int ai = 0; ai < 2; ++ai)
#pragma unroll
                    for (int m = 0; m < 4; ++m) {
                        const size_t row = (size_t)(row0 + ai * HALF + m * 16);
                        f32x4 v0 = acc[ai][bj][m][0], v1 = acc[ai][bj][m][1];
                        if constexpr (MODE == 2) {
                            v0 = v0 + bv0; v1 = v1 + bv1;
#pragma unroll
                            for (int e = 0; e < 4; ++e) { v0[e] = sigmoid_f(v0[e]); v1[e] = sigmoid_f(v1[e]); }
                        }
                        if constexpr (MODE == 3) {
                            const u32x4 g = *(const u32x4*)(G + row * ldg + c);
                            v0[0] *= bf_lo(g.x); v0[1] *= bf_hi(g.x); v0[2] *= bf_lo(g.y); v0[3] *= bf_hi(g.y);
                            v1[0] *= bf_lo(g.z); v1[1] *= bf_hi(g.z); v1[2] *= bf_lo(g.w); v1[3] *= bf_hi(g.w);
                            if (accum) {
                                const u32x4 pv = *(const u32x4*)(O + row * ldc + c);
                                v0[0] += bf_lo(pv.x); v0[1] += bf_hi(pv.x); v0[2] += bf_lo(pv.y); v0[3] += bf_hi(pv.y);
                                v1[0] += bf_lo(pv.z); v1[1] += bf_hi(pv.z); v1[2] += bf_lo(pv.w); v1[3] += bf_hi(pv.w);
                            }
                        }
                        u32x4 w; w.x = cvt_pk_bf16(v0[0], v0[1]); w.y = cvt_pk_bf16(v0[2], v0[3]); w.z = cvt_pk_bf16(v1[0], v1[1]); w.w = cvt_pk_bf16(v1[2], v1[3]);
                        *(u32x4*)(O + row * ldc + c) = w;
                    }
            }
        }
    }
};

template <class Epi, class Sched, bool ALIGN_EPI = true>
__device__ __forceinline__ void gemm_phase(PG8_LAS unsigned char* lds, const Gemm g, const Sched& S, const Epi& E, const int tid) {
    const int wid = __builtin_amdgcn_readfirstlane(tid >> 6), lane = tid & 63, wr = wid >> 2, wc = wid & 3, fr = lane & 15, fq = lane >> 4;
    const int K = g.K, nt = K / BK, lda = g.lda;
    unsigned voffA[2], voffB[2];
#pragma unroll
    for (int i = 0; i < 2; ++i) { int R, C; stage_rc(tid * 16 + i * 8192, R, C); const int Rb = Epi::PERM ? ((R & ~31) + perm32(R & 31)) : R;
        voffA[i] = (unsigned)(R * lda + C) * 2u; voffB[i] = (unsigned)(Rb * K + C) * 2u; }
    const size_t kstep = (size_t)(BK * 2);
    const size_t hstepA = (size_t)HALF * lda * 2, hstepB = (size_t)HALF * K * 2;
    const size_t tstepA = 2 * hstepA, tstepB = 2 * hstepB;
    const unsigned ldsw = (unsigned)wid * 1024u;
    const int aoff = lds_byte(wr * 64 + fr, fq * 8), boff = lds_byte(wc * 32 + fr, fq * 8);
#define PG8_SA(b, h) (((b) * 2 + (h)) * HTB)
#define PG8_SB(b, h) ((4 + (b) * 2 + (h)) * HTB)
#define PG8_STAGE(bufoff, gbase, voff) do { _Pragma("unroll") for (int _i = 0; _i < 2; ++_i) \
        __builtin_amdgcn_global_load_lds((const unsigned*)((const char*)(gbase) + (voff)[_i]), (PG8_LAS unsigned*)(lds + (bufoff) + ldsw + _i * 8192), 16, 0, 0); } while (0)
#define PG8_LDA(dst, b, h) do { _Pragma("unroll") for (int m = 0; m < 4; ++m) _Pragma("unroll") for (int k = 0; k < 2; ++k) dst[m][k] = *(const PG8_LAS bf16x8*)(lds + PG8_SA(b, h) + aoff + m * 2048 + k * 1024); } while (0)
#define PG8_LDB(dst, b, h) do { _Pragma("unroll") for (int n = 0; n < 2; ++n) _Pragma("unroll") for (int k = 0; k < 2; ++k) dst[n][k] = *(const PG8_LAS bf16x8*)(lds + PG8_SB(b, h) + boff + n * 2048 + k * 1024); } while (0)
#define PG8_MMA(ai, bj, At, Bt) do { __builtin_amdgcn_s_setprio(1); _Pragma("unroll") for (int m = 0; m < 4; ++m) _Pragma("unroll") for (int n = 0; n < 2; ++n) _Pragma("unroll") for (int k = 0; k < 2; ++k) \
        acc[ai][bj][m][n] = __builtin_amdgcn_mfma_f32_16x16x32_bf16(Bt[n][k], At[m][k], acc[ai][bj][m][n], 0, 0, 0); __builtin_amdgcn_s_setprio(0); } while (0)
#define PG8_WAIT_V(n) asm volatile("s_waitcnt vmcnt(" #n ")" ::: "memory")
#define PG8_WAIT_L(n) asm volatile("s_waitcnt lgkmcnt(" #n ")" ::: "memory")
#define PG8_BAR __builtin_amdgcn_s_barrier()
#define PG8_SCHED __builtin_amdgcn_sched_barrier(0)
    Unit cur, nxt; int ui = 0;
    if (!S.next(0, cur)) return;
    f32x4 acc[2][2][4][2];
#pragma unroll
    for (int a = 0; a < 2; ++a)
#pragma unroll
        for (int b = 0; b < 2; ++b)
#pragma unroll
            for (int m = 0; m < 4; ++m)
#pragma unroll
                for (int n = 0; n < 2; ++n) acc[a][b][m][n] = (f32x4){0.f, 0.f, 0.f, 0.f};
    bf16x8 At[4][2], B0[2][2], B1[2][2];
    const char* cA = (const char*)g.A + (size_t)cur.pm * tstepA; const char* cB = (const char*)g.Bt + (size_t)cur.pn * tstepB;
    S.a_ready(cur);
    PG8_STAGE(PG8_SB(0, 0), cB, voffB); PG8_STAGE(PG8_SB(0, 1), cB + hstepB, voffB); PG8_STAGE(PG8_SA(0, 0), cA, voffA); PG8_STAGE(PG8_SA(0, 1), cA + hstepA, voffA);
    if (wr == 1) PG8_BAR;
    PG8_WAIT_V(2); PG8_BAR;
    PG8_STAGE(PG8_SB(1, 0), cB + kstep, voffB); PG8_STAGE(PG8_SA(1, 0), cA + kstep, voffA); PG8_STAGE(PG8_SB(1, 1), cB + hstepB + kstep, voffB);
    PG8_WAIT_V(6); PG8_BAR;
    for (;;) {
        const bool has_next = S.next(ui + 1, nxt);
        const char* nA = has_next ? (const char*)g.A + (size_t)nxt.pm * tstepA : cA; const char* nB = has_next ? (const char*)g.Bt + (size_t)nxt.pn * tstepB : cB;
        for (int t = 0; t < nt; t += 2) {
            const bool last = (t == nt - 2);
            const char* a1 = cA + (size_t)(t + 1) * kstep;
            const char* a2 = last ? nA : cA + (size_t)(t + 2) * kstep; const char* b2 = last ? nB : cB + (size_t)(t + 2) * kstep;
            const char* a3 = a2 + kstep; const char* b3 = b2 + kstep;
            if (last && has_next) S.a_ready(nxt);
            PG8_LDB(B0, 0, 0); PG8_LDB(B1, 0, 1); PG8_SCHED; PG8_LDA(At, 0, 0); PG8_STAGE(PG8_SA(1, 1), a1 + hstepA, voffA);
            PG8_WAIT_V(8); PG8_WAIT_L(0); PG8_BAR; PG8_MMA(0, 0, At, B0); PG8_MMA(0, 1, At, B1); PG8_BAR; PG8_SCHED;
            PG8_LDA(At, 0, 1); PG8_STAGE(PG8_SB(0, 0), b2, voffB); PG8_STAGE(PG8_SB(0, 1), b2 + hstepB, voffB); PG8_STAGE(PG8_SA(0, 0), a2, voffA);
            PG8_WAIT_V(8); PG8_WAIT_L(0); PG8_BAR; PG8_MMA(1, 0, At, B0); PG8_MMA(1, 1, At, B1); PG8_BAR; PG8_SCHED;
            PG8_LDB(B0, 1, 0); PG8_LDB(B1, 1, 1); PG8_SCHED; PG8_LDA(At, 1, 0); PG8_STAGE(PG8_SA(0, 1), a2 + hstepA, voffA);
            PG8_WAIT_V(8); PG8_WAIT_L(0); PG8_BAR; PG8_MMA(0, 0, At, B0); PG8_MMA(0, 1, At, B1); PG8_BAR; PG8_SCHED;
            PG8_LDA(At, 1, 1); PG8_STAGE(PG8_SB(1, 0), b3, voffB); PG8_STAGE(PG8_SB(1, 1), b3 + hstepB, voffB); PG8_STAGE(PG8_SA(1, 0), a3, voffA);
            PG8_WAIT_V(8); PG8_WAIT_L(0); PG8_BAR; PG8_MMA(1, 0, At, B0); PG8_MMA(1, 1, At, B1); PG8_BAR; PG8_SCHED;
        }
        if constexpr (ALIGN_EPI) { if (wr == 0) PG8_BAR; }
        E(acc, cur, wr, wc, fr, fq); S.done(cur);
        if (!has_next) break;
#pragma unroll
        for (int a = 0; a < 2; ++a)
#pragma unroll
            for (int b = 0; b < 2; ++b)
#pragma unroll
                for (int m = 0; m < 4; ++m)
#pragma unroll
                    for (int n = 0; n < 2; ++n) acc[a][b][m][n] = (f32x4){0.f, 0.f, 0.f, 0.f};
        cur = nxt; cA = nA; cB = nB; ++ui;
        if constexpr (ALIGN_EPI) { if (wr == 1) PG8_BAR; }
    }
    PG8_WAIT_V(0);
    if constexpr (!ALIGN_EPI) { if (wr == 0) PG8_BAR; }
    PG8_BAR;
#undef PG8_SA
#undef PG8_SB
#undef PG8_STAGE
#undef PG8_LDA
#undef PG8_LDB
#undef PG8_MMA
#undef PG8_WAIT_V
#undef PG8_WAIT_L
#undef PG8_BAR
#undef PG8_SCHED
}
}

typedef unsigned short bf16;
typedef short bf16x8 __attribute__((ext_vector_type(8)));
typedef float f32x4 __attribute__((ext_vector_type(4)));
typedef float f32x16 __attribute__((ext_vector_type(16)));
typedef unsigned v4u __attribute__((ext_vector_type(4)));
typedef unsigned v2u __attribute__((ext_vector_type(2)));

constexpr int DM = 1024, NBATCH = 4, SEQ = 8192, MTOK = NBATCH * SEQ, FFN = 2816, PIN = 2048, NGATE = 3072, MEMLEN = 256, MEMROWS = NBATCH * MEMLEN;
constexpr int NWAVES = 8;
constexpr float EPSN = 1e-6f;
constexpr float LOG2E = 1.4426950408889634f, LN2 = 0.6931471805599453f;
constexpr float C2 = 0.125f * LOG2E;

constexpr size_t MiB = (size_t)1 << 20;
constexpr size_t WS_WB = 1 * MiB, WS_KVMEM = 49 * MiB, WS_MH = 50 * MiB, WS_LSE = 52 * MiB, WS_XN = 54 * MiB, WS_R = 118 * MiB;
constexpr size_t WS_H = WS_R, WS_YF = WS_R + 176 * MiB;
constexpr size_t WS_Z = WS_R, WS_GATES = WS_R + 128 * MiB, WS_OALL = WS_R + 320 * MiB, WS_MERGED = WS_R, WS_YM = WS_R + 64 * MiB;
constexpr size_t WS_END = WS_R + 384 * MiB;
constexpr size_t WO_F1IN = 0, WO_F1OUT = 5767168, WO_WIN = 8650752, WO_WGATE = 10747904, WO_BRA = 13893632, WO_BRB = 14286848, WO_BRC = 14680064,
                 WO_WO = 14942208, WO_F2IN = 15990784, WO_F2OUT = 21757952, WO_MEMKV = 24641536;
constexpr int RING_BYTES = 131072, LUT_OFF = RING_BYTES, LUT_PITCH = 132, LDS_BYTES = 147456;

struct Params { const float* in[18]; float* out; unsigned char* ws; int ph_lo, ph_hi, coop, pad; };

#define LDS_WAIT() asm volatile("s_waitcnt lgkmcnt(0)" ::: "memory")
__device__ __forceinline__ unsigned pk2(float lo, float hi) { return pg8::cvt_pk_bf16(lo, hi); }
__device__ __forceinline__ float wave_sum(float v) {
#pragma unroll
    for (int o = 1; o < 64; o <<= 1) v += __shfl_xor(v, o);
    return v;
}

__device__ __forceinline__ void transpose_item(const float* W, int K, int N, bf16* WT, int k0, int n0, int rowbase, LAS float* scr, int lane) {
#pragma unroll 8
    for (int i = 0; i < 32; ++i) { const int kk = 2 * i + (lane >> 5); scr[kk * 33 + (lane & 31)] = W[(size_t)(k0 + kk) * N + n0 + (lane & 31)]; }
    LDS_WAIT(); asm volatile("" ::: "memory");
    const int c = lane & 7;
#pragma unroll
    for (int j = 0; j < 4; ++j) { const int n = (lane >> 3) + 8 * j; const LAS float* s = scr + (8 * c) * 33 + n;
        v4u o; o.x = pk2(s[0 * 33], s[1 * 33]); o.y = pk2(s[2 * 33], s[3 * 33]); o.z = pk2(s[4 * 33], s[5 * 33]); o.w = pk2(s[6 * 33], s[7 * 33]);
        *(v4u*)(WT + (size_t)(rowbase + n) * K + k0 + 8 * c) = o; }
    LDS_WAIT(); asm volatile("" ::: "memory");
}
__device__ __forceinline__ void tr_plain(const float* W, int K, int N, bf16* WT, int r, LAS float* scr, int lane) {
    const int nblk = N / 32, kb = r / nblk, nb = r % nblk;
    transpose_item(W, K, N, WT, 64 * kb, 32 * nb, 32 * nb, scr, lane);
}
__device__ __forceinline__ void tr_ffnin(const float* W, bf16* WT, int r, LAS float* scr, int lane) {
    const int nblk = (2 * FFN) / 32, kb = r / nblk, nb = r % nblk, n0 = 32 * nb;
    const int isb = n0 >= FFN ? 1 : 0, j = n0 - isb * FFN;
    const int rowbase = (j >> 7) * 256 + isb * 128 + (j & 127);
    transpose_item(W, DM, 2 * FFN, WT, 64 * kb, n0, rowbase, scr, lane);
}

__device__ __forceinline__ void convert_weights(const Params& p, int l, bf16* WB, LAS unsigned char* lds, int gw, int ngw, int wave, int lane) {
    LAS float* scr = (LAS float*)(lds + wave * 16384);
    constexpr int I_FIN = 16 * 176, I_FOUT = 44 * 32, I_WIN = 16 * 64, I_WG = 16 * 96, I_BRA = 6 * 32, I_BRC = 4 * 32, I_WO = 16 * 32, I_MKV = 16 * 16;
    constexpr int NITEMS = 2 * I_FIN + 2 * I_FOUT + I_WIN + I_WG + 2 * I_BRA + I_BRC + I_WO + I_MKV;
    const float* f1in = p.in[5] + (size_t)l * DM * 2 * FFN; const float* f1out = p.in[6] + (size_t)l * FFN * DM;
    const float* win = p.in[7] + (size_t)l * DM * PIN; const float* wmkv = p.in[9] + (size_t)l * DM * 512;
    const float* wgate = p.in[10] + (size_t)l * DM * NGATE;
    const float* bra = p.in[12] + (size_t)l * 384 * DM; const float* brb = p.in[13] + (size_t)l * 384 * DM; const float* brc = p.in[14] + (size_t)l * 256 * DM;
    const float* wo = p.in[15] + (size_t)l * DM * DM; const float* f2in = p.in[16] + (size_t)l * DM * 2 * FFN; const float* f2out = p.in[17] + (size_t)l * FFN * DM;
    for (int it = gw; it < NITEMS; it += ngw) {
        int r = it;
        if (r < I_FIN) { tr_ffnin(f1in, WB + WO_F1IN, r, scr, lane); continue; } r -= I_FIN;
        if (r < I_FIN) { tr_ffnin(f2in, WB + WO_F2IN, r, scr, lane); continue; } r -= I_FIN;
        if (r < I_FOUT) { tr_plain(f1out, FFN, DM, WB + WO_F1OUT, r, scr, lane); continue; } r -= I_FOUT;
        if (r < I_FOUT) { tr_plain(f2out, FFN, DM, WB + WO_F2OUT, r, scr, lane); continue; } r -= I_FOUT;
        if (r < I_WIN) { tr_plain(win, DM, PIN, WB + WO_WIN, r, scr, lane); continue; } r -= I_WIN;
        if (r < I_WG) { tr_plain(wgate, DM, NGATE, WB + WO_WGATE, r, scr, lane); continue; } r -= I_WG;
        if (r < I_BRA) { tr_plain(bra, 384, DM, WB + WO_BRA, r, scr, lane); continue; } r -= I_BRA;
        if (r < I_BRA) { tr_plain(brb, 384, DM, WB + WO_BRB, r, scr, lane); continue; } r -= I_BRA;
        if (r < I_BRC) { tr_plain(brc, 256, DM, WB + WO_BRC, r, scr, lane); continue; } r -= I_BRC;
        if (r < I_WO) { tr_plain(wo, DM, DM, WB + WO_WO, r, scr, lane); continue; } r -= I_WO;
        tr_plain(wmkv, DM, 512, WB + WO_MEMKV, r, scr, lane);
    }
}

__device__ __forceinline__ void row_pass(const float* xin, const bf16* y, const float* gpost, float scale, float* xout, const float* gpre, bf16* xn, int lane) {
    const f32x4* xr = (const f32x4*)xin + lane;
    f32x4 v[4];
#pragma unroll
    for (int j = 0; j < 4; ++j) v[j] = xr[64 * j];
    if (y) {
        const v2u* yr = (const v2u*)y + lane;
        f32x4 yv[4]; float ss = 0.f;
#pragma unroll
        for (int j = 0; j < 4; ++j) { const v2u w = yr[64 * j]; yv[j] = (f32x4){pg8::bf_lo(w.x), pg8::bf_hi(w.x), pg8::bf_lo(w.y), pg8::bf_hi(w.y)};
            ss += (yv[j].x * yv[j].x + yv[j].y * yv[j].y) + (yv[j].z * yv[j].z + yv[j].w * yv[j].w); }
        const float rs = scale / sqrtf(wave_sum(ss) * (1.f / DM) + EPSN);
#pragma unroll
        for (int j = 0; j < 4; ++j) { const f32x4 g = ((const f32x4*)gpost)[lane + 64 * j]; v[j] = v[j] + yv[j] * g * rs; }
    }
    if (xout) {
        f32x4* xo = (f32x4*)xout + lane;
#pragma unroll
        for (int j = 0; j < 4; ++j) xo[64 * j] = v[j];
    }
    if (xn) {
        float s2 = 0.f;
#pragma unroll
        for (int j = 0; j < 4; ++j) s2 += (v[j].x * v[j].x + v[j].y * v[j].y) + (v[j].z * v[j].z + v[j].w * v[j].w);
        const float rstd = 1.f / sqrtf(wave_sum(s2) * (1.f / DM) + EPSN);
        v2u* o8 = (v2u*)xn + lane;
#pragma unroll
        for (int j = 0; j < 4; ++j) { const f32x4 g = ((const f32x4*)gpre)[lane + 64 * j]; const f32x4 t = v[j] * g * rstd;
            v2u w; w.x = pk2(t.x, t.y); w.y = pk2(t.z, t.w); o8[64 * j] = w; }
    }
}

__device__ __forceinline__ int crow(int r, int hi) { return (r & 3) + 8 * (r >> 2) + 4 * hi; }
#define MFMA32(a, b, c) __builtin_amdgcn_mfma_f32_32x32x16_bf16((a), (b), (c), 0, 0, 0)

template <bool MASKED>
__device__ __forceinline__ void attn_wave(const bf16* qp, long qstep, const bf16* kp, long kstep, const bf16* vp, long vstep, bf16* op, long ostep,
                                          float* lsep, long lsestep, int i0, int t_lo, int t_hi, int maxd, const LAS float* lut, float m0, float l0, int lane) {
    const int q = lane & 31, hi = lane >> 5, qi = i0 + q;
    bf16x8 qf[4];
    { const bf16* qrow = qp + (long)qi * qstep + 8 * hi;
#pragma unroll
      for (int d0 = 0; d0 < 4; ++d0) qf[d0] = *(const bf16x8*)(qrow + 16 * d0); }
    float m = m0, l = (hi == 0) ? l0 : 0.f;
    f32x16 o0, o1;
#pragma unroll
    for (int r = 0; r < 16; ++r) { o0[r] = 0.f; o1[r] = 0.f; }
    for (int t = t_lo; t <= t_hi; ++t) {
        const int kv0 = 32 * t;
        bf16x8 kf[4];
        { const bf16* krow = kp + (long)(kv0 + q) * kstep + 8 * hi;
#pragma unroll
          for (int d0 = 0; d0 < 4; ++d0) kf[d0] = *(const bf16x8*)(krow + 16 * d0); }
        f32x16 p;
#pragma unroll
        for (int r = 0; r < 16; ++r) p[r] = 0.f;
#pragma unroll
        for (int d0 = 0; d0 < 4; ++d0) p = MFMA32(kf[d0], qf[d0], p);
        float tmax = -INFINITY;
#pragma unroll
        for (int r = 0; r < 16; ++r) {
            float s = p[r] * C2;
            if (MASKED) {
                const int dist = qi - (kv0 + crow(r, hi));
                const bool ok = (dist >= 0) && (dist <= maxd);
                const int di = dist < 0 ? 0 : (dist > 128 ? 128 : dist);
                s += lut[di];
                s = ok ? s : -INFINITY;
            }
            p[r] = s; tmax = fmaxf(tmax, s);
        }
        tmax = fmaxf(tmax, __shfl_xor(tmax, 32));
        const float mn = fmaxf(m, tmax);
        const float sc = __builtin_amdgcn_exp2f(m - mn);
        m = mn; l *= sc;
#pragma unroll
        for (int r = 0; r < 16; ++r) { o0[r] *= sc; o1[r] *= sc; }
        float ps = 0.f;
#pragma unroll
        for (int r = 0; r < 16; ++r) { const float e = __builtin_amdgcn_exp2f(p[r] - mn); p[r] = e; ps += e; }
        l += ps;
        v4u pw0, pw1;
        pw0.x = pk2(p[0], p[1]); pw0.y = pk2(p[2], p[3]); pw0.z = pk2(p[4], p[5]); pw0.w = pk2(p[6], p[7]);
        pw1.x = pk2(p[8], p[9]); pw1.y = pk2(p[10], p[11]); pw1.z = pk2(p[12], p[13]); pw1.w = pk2(p[14], p[15]);
        const bf16x8 pb0 = __builtin_bit_cast(bf16x8, pw0), pb1 = __builtin_bit_cast(bf16x8, pw1);
#pragma unroll
        for (int s = 0; s < 2; ++s) {
#pragma unroll
            for (int db = 0; db < 2; ++db) {
                bf16x8 va;
#pragma unroll
                for (int j = 0; j < 8; ++j) { const int kk = kv0 + 16 * s + 8 * (j >> 2) + 4 * hi + (j & 3); va[j] = (short)vp[(long)kk * vstep + 32 * db + q]; }
                if (db == 0) o0 = MFMA32(va, s == 0 ? pb0 : pb1, o0); else o1 = MFMA32(va, s == 0 ? pb0 : pb1, o1);
            }
        }
    }
    l += __shfl_xor(l, 32);
    const float inv = 1.f / l;
    bf16* orow = op + (long)qi * ostep + 4 * hi;
#pragma unroll
    for (int g = 0; g < 4; ++g) {
        v2u w0, w1;
        w0.x = pk2(o0[4 * g] * inv, o0[4 * g + 1] * inv); w0.y = pk2(o0[4 * g + 2] * inv, o0[4 * g + 3] * inv);
        w1.x = pk2(o1[4 * g] * inv, o1[4 * g + 1] * inv); w1.y = pk2(o1[4 * g + 2] * inv, o1[4 * g + 3] * inv);
        *(v2u*)(orow + 8 * g) = w0; *(v2u*)(orow + 32 + 8 * g) = w1;
    }
    if (lsep && hi == 0) lsep[(long)qi * lsestep] = m * LN2 + logf(l);
}

struct Job { int mode; const bf16* A; int lda; const bf16* Bt; int M, N, K; bf16* O; int ldc; const float* bias; const bf16* G; int ldg; int accum; };

__device__ __forceinline__ void run_job(const Job& J, LAS unsigned char* lds, int G, int bid, int tid) {
    pg8::Gemm g{J.A, J.Bt, J.M, J.N, J.K, J.lda};
    pg8::StaticOrder S; S.init(J.M, J.N, G, bid);
    if (J.mode == 0) { pg8::Epi<0> E{J.O, J.ldc, J.bias, J.G, J.ldg, J.accum}; pg8::gemm_phase<pg8::Epi<0>, pg8::StaticOrder, true>(lds, g, S, E, tid); }
    else if (J.mode == 1) { pg8::Epi<1> E{J.O, J.ldc, J.bias, J.G, J.ldg, J.accum}; pg8::gemm_phase<pg8::Epi<1>, pg8::StaticOrder, true>(lds, g, S, E, tid); }
    else if (J.mode == 2) { pg8::Epi<2> E{J.O, J.ldc, J.bias, J.G, J.ldg, J.accum}; pg8::gemm_phase<pg8::Epi<2>, pg8::StaticOrder, true>(lds, g, S, E, tid); }
    else { pg8::Epi<3> E{J.O, J.ldc, J.bias, J.G, J.ldg, J.accum}; pg8::gemm_phase<pg8::Epi<3>, pg8::StaticOrder, true>(lds, g, S, E, tid); }
}

__global__ void __launch_bounds__(NWAVES * 64, 2) mega_fwd(Params p) {
    extern __shared__ __attribute__((aligned(16))) unsigned char lds_raw[];
    LAS unsigned char* lds = (LAS unsigned char*)lds_raw;
    const int G = gridDim.x, bid = blockIdx.x;
    LAS float* lut = (LAS float*)(lds + LUT_OFF);
    const float* rel_bias = p.in[2];
    const int tid = threadIdx.x;

    for (int i = tid; i < 12 * 129; i += NWAVES * 64) {
        const int h = i / 129, dist = i % 129;
        const int rate = h < 8 ? 1 : (h < 10 ? 4 : 16);
        const int d = dist * rate;
        int bucket;
        if (d < 16) bucket = d;
        else { const float fd = (float)d; int large = 16 + (int)(logf(fd / 16.0f) / 4.852030263919617f * 16.0f); bucket = large < 31 ? large : 31; }
        lut[h * LUT_PITCH + dist] = rel_bias[bucket * 12 + h] * LOG2E;
    }
    __syncthreads();

    cg::grid_group grid = cg::this_grid();
    for (int ph = p.ph_lo; ph < p.ph_hi; ++ph) {
        int tidv = threadIdx.x; asm volatile("" : "+v"(tidv));
        const int lane = tidv & 63, wave = __builtin_amdgcn_readfirstlane(tidv >> 6);
        const int gw = bid * NWAVES + wave, ngw = G * NWAVES;
        unsigned char* ws = p.ws; asm volatile("" : "+s"(ws));
        float* out = p.out; asm volatile("" : "+s"(out));
        bf16* WB = (bf16*)(ws + WS_WB); bf16* KVMEM = (bf16*)(ws + WS_KVMEM); bf16* MH = (bf16*)(ws + WS_MH); float* LSE = (float*)(ws + WS_LSE);
        bf16* XN = (bf16*)(ws + WS_XN); bf16* H = (bf16*)(ws + WS_H); bf16* YF = (bf16*)(ws + WS_YF); bf16* Z = (bf16*)(ws + WS_Z);
        bf16* GATES = (bf16*)(ws + WS_GATES); bf16* OALL = (bf16*)(ws + WS_OALL); bf16* MERGED = (bf16*)(ws + WS_MERGED); bf16* YM = (bf16*)(ws + WS_YM);
        const float* x_in = p.in[0]; const float* mem = p.in[1]; const float* norm_gain = p.in[3]; const float* mem_gain = p.in[4];
        const float* sinks = p.in[8]; const float* b_gate = p.in[11];
        if (ph == 0) {
            convert_weights(p, 0, WB, lds, gw, ngw, wave, lane);
            for (int m = gw; m < MEMROWS; m += ngw) row_pass(mem + (size_t)m * DM, nullptr, nullptr, 0.f, nullptr, mem_gain, MH + (size_t)m * DM, lane);
            for (int m = gw; m < MTOK; m += ngw) row_pass(x_in + (size_t)m * DM, nullptr, nullptr, 0.f, nullptr, norm_gain, XN + (size_t)m * DM, lane);
        } else {
            const int l = (ph - 1) / 12, lp = (ph - 1) % 12;
            const float* gn = norm_gain + (size_t)l * 6 * DM;
            if (lp == 0 || lp == 1 || lp == 2 || lp == 3 || lp == 6 || lp == 7 || lp == 9 || lp == 10) {
                const int njobs = (lp == 3) ? 2 : (lp == 6 ? 3 : 1);
                for (int j = 0; j < njobs; ++j) {
                    Job J; J.bias = nullptr; J.G = nullptr; J.ldg = 0; J.accum = 0; J.M = MTOK;
                    if (lp == 0 || lp == 9) { J.mode = 1; J.A = XN; J.lda = DM; J.K = DM; J.Bt = WB + (lp == 0 ? WO_F1IN : WO_F2IN); J.N = 2 * FFN; J.O = H; J.ldc = FFN; }
                    else if (lp == 1 || lp == 10) { J.mode = 0; J.A = H; J.lda = FFN; J.K = FFN; J.Bt = WB + (lp == 1 ? WO_F1OUT : WO_F2OUT); J.N = DM; J.O = YF; J.ldc = DM; }
                    else if (lp == 2) { J.mode = 0; J.A = MH; J.lda = DM; J.K = DM; J.Bt = WB + WO_MEMKV; J.M = MEMROWS; J.N = 512; J.O = KVMEM; J.ldc = 512; }
                    else if (lp == 3) {
                        if (j == 0) { J.mode = 0; J.A = XN; J.lda = DM; J.K = DM; J.Bt = WB + WO_WIN; J.N = PIN; J.O = Z; J.ldc = PIN; }
                        else { J.mode = 2; J.A = XN; J.lda = DM; J.K = DM; J.Bt = WB + WO_WGATE; J.N = NGATE; J.O = GATES; J.ldc = NGATE; J.bias = b_gate + (size_t)l * NGATE; }
                    }
                    else if (lp == 6) {
                        J.mode = 3; J.lda = DM; J.N = DM; J.O = MERGED; J.ldc = DM; J.ldg = NGATE; J.accum = j > 0 ? 1 : 0;
                        if (j == 0) { J.A = OALL; J.K = 384; J.Bt = WB + WO_BRA; J.G = GATES; }
                        else if (j == 1) { J.A = OALL + 384; J.K = 384; J.Bt = WB + WO_BRB; J.G = GATES + DM; }
                        else { J.A = OALL + 768; J.K = 256; J.Bt = WB + WO_BRC; J.G = GATES + 2 * DM; }
                    }
                    else { J.mode = 0; J.A = MERGED; J.lda = DM; J.K = DM; J.Bt = WB + WO_WO; J.N = DM; J.O = YM; J.ldc = DM; }
                    run_job(J, lds, G, bid, tidv);
                }
            }
            if (lp == 2) {
                const float* xin = (l == 0) ? x_in : out;
                for (int m = gw; m < MTOK; m += ngw) row_pass(xin + (size_t)m * DM, YF + (size_t)m * DM, gn + 1 * DM, 0.5f, out + (size_t)m * DM, gn + 2 * DM, XN + (size_t)m * DM, lane);
            } else if (lp == 4) {
                for (int tk = gw; tk < 6144; tk += ngw) {
                    const int sl = tk & 255, b = (tk >> 8) & 3, hd = tk >> 10;
                    const int gi = hd >> 1, sh = 2 * gi;
                    const int spr = 256 >> sh;
                    const int rho = sl / spr, i0 = 32 * (sl % spr);
                    const long row0 = (long)b * SEQ + rho, st = 1L << sh;
                    const int t_hi = i0 >> 5, t_lo = t_hi >= 4 ? t_hi - 4 : 0;
                    attn_wave<true>(Z + row0 * PIN + 640 + hd * 64, st * PIN, Z + row0 * PIN + 1024 + hd * 64, st * PIN, Z + row0 * PIN + 1408 + hd * 64, st * PIN,
                                    OALL + row0 * DM + 384 + hd * 64, st * DM, LSE + row0 * 6 + hd, st * 6, i0, t_lo, t_hi, 128, lut + (6 + hd) * LUT_PITCH, -1e30f, 0.f, lane);
                }
            } else if (lp == 5) {
                for (int tk = gw; tk < 6144; tk += ngw) {
                    const int sl = tk & 255, bh = tk >> 8, b = bh / 6, h = bh % 6, kvh = h / 3;
                    const int i0 = 32 * sl; const long row0 = (long)b * SEQ;
                    const int t_hi = sl, t_lo = t_hi >= 4 ? t_hi - 4 : 0;
                    attn_wave<true>(Z + row0 * PIN + h * 64, PIN, Z + row0 * PIN + 384 + kvh * 64, PIN, Z + row0 * PIN + 512 + kvh * 64, PIN,
                                    OALL + row0 * DM + h * 64, DM, nullptr, 0, i0, t_lo, t_hi, 127, lut + h * LUT_PITCH, sinks[l * 6 + h] * LOG2E, 1.f, lane);
                }
                for (int tk = gw; tk < 4096; tk += ngw) {
                    const int sl = tk & 255, bh = tk >> 8, b = bh >> 2, h = bh & 3;
                    const long row0 = (long)b * SEQ;
                    attn_wave<false>(Z + row0 * PIN + 1792 + h * 64, PIN, KVMEM + (long)b * MEMLEN * 512 + h * 64, 512, KVMEM + (long)b * MEMLEN * 512 + 256 + h * 64, 512,
                                     OALL + row0 * DM + 768 + h * 64, DM, nullptr, 0, 32 * sl, 0, 7, 0, lut, -1e30f, 0.f, lane);
                }
                for (int idx = bid * (NWAVES * 64) + tidv; idx < MTOK * 48; idx += G * NWAVES * 64) {
                    const int t = idx / 48, c = idx % 48, head = c >> 3, hg = head & 1;
                    const float* ls = LSE + (size_t)t * 6;
                    const float a0 = ls[hg], a1 = ls[2 + hg], a2 = ls[4 + hg], mine = ls[head];
                    const float mx = fmaxf(a0, fmaxf(a1, a2));
                    const float den = __expf(a0 - mx) + __expf(a1 - mx) + __expf(a2 - mx);
                    const float alpha = __expf(mine - mx) / den;
                    v4u* pp = (v4u*)(OALL + (size_t)t * DM + 384 + c * 8);
                    const v4u w = *pp; v4u o;
                    o.x = pk2(pg8::bf_lo(w.x) * alpha, pg8::bf_hi(w.x) * alpha); o.y = pk2(pg8::bf_lo(w.y) * alpha, pg8::bf_hi(w.y) * alpha);
                    o.z = pk2(pg8::bf_lo(w.z) * alpha, pg8::bf_hi(w.z) * alpha); o.w = pk2(pg8::bf_lo(w.w) * alpha, pg8::bf_hi(w.w) * alpha);
                    *pp = o;
                }
            } else if (lp == 8) {
                for (int m = gw; m < MTOK; m += ngw) row_pass(out + (size_t)m * DM, YM + (size_t)m * DM, gn + 3 * DM, 1.0f, out + (size_t)m * DM, gn + 4 * DM, XN + (size_t)m * DM, lane);
            } else if (lp == 11) {
                const bool more = (l == 0);
                for (int m = gw; m < MTOK; m += ngw) row_pass(out + (size_t)m * DM, YF + (size_t)m * DM, gn + 5 * DM, 0.5f, out + (size_t)m * DM,
                                                                more ? norm_gain + 6 * DM : nullptr, more ? XN + (size_t)m * DM : nullptr, lane);
                if (more) {
                    convert_weights(p, 1, WB, lds, gw, ngw, wave, lane);
                    for (int m = gw; m < MEMROWS; m += ngw) row_pass(mem + (size_t)m * DM, nullptr, nullptr, 0.f, nullptr, mem_gain + DM, MH + (size_t)m * DM, lane);
                }
            }
        }
        if (p.coop && ph + 1 < p.ph_hi) grid.sync();
        else __syncthreads();
    }
}

constexpr int N_PHASES = 25;
extern "C" void kernel_launch(void* const* d_in, const int* in_sizes, int n_in, void* d_out, int out_size, void* d_ws, size_t ws_size, hipStream_t stream) {
    static int grid = 0;
    if (grid == 0) {
        if (n_in != 18 || in_sizes[0] != MTOK * DM || out_size != MTOK * DM || ws_size < WS_END) {
            fprintf(stderr, "kernel_launch: unexpected shapes (n_in %d, in0 %d, out %d, ws %zu < %zu); nothing launched\n", n_in, n_in > 0 ? in_sizes[0] : -1, out_size, ws_size, (size_t)WS_END);
            grid = -1; return; }
        int dev = 0, cus = 0, per_cu = 0;
        if (hipGetDevice(&dev) != hipSuccess || hipDeviceGetAttribute(&cus, hipDeviceAttributeMultiprocessorCount, dev) != hipSuccess) { grid = -1; return; }
        if (hipFuncSetAttribute((const void*)mega_fwd, hipFuncAttributeMaxDynamicSharedMemorySize, LDS_BYTES) != hipSuccess) { fprintf(stderr, "kernel_launch: hipFuncSetAttribute failed\n"); grid = -1; return; }
        if (hipOccupancyMaxActiveBlocksPerMultiprocessor(&per_cu, (const void*)mega_fwd, NWAVES * 64, LDS_BYTES) != hipSuccess || per_cu < 1) { fprintf(stderr, "kernel_launch: occupancy query reports %d\n", per_cu); per_cu = 1; }
        (void)hipGetLastError();
        grid = cus;
        if (grid != 256) fprintf(stderr, "kernel_launch: note: %d CUs\n", grid);
    }
    if (grid < 0) return;
    Params p{};
    for (int i = 0; i < 18; ++i) p.in[i] = (const float*)d_in[i];
    p.out = (float*)d_out; p.ws = (unsigned char*)d_ws;
#if ONE_LAUNCH
    p.ph_lo = 0; p.ph_hi = N_PHASES; p.coop = 1; p.pad = 0;
    void* args[] = {&p};
    hipError_t e = hipLaunchCooperativeKernel((const void*)mega_fwd, dim3(grid), dim3(NWAVES * 64), args, LDS_BYTES, stream);
    if (e != hipSuccess) fprintf(stderr, "cooperative launch failed: %s (grid %d)\n", hipGetErrorString(e), grid);
#else
    for (int ph = 0; ph < N_PHASES; ++ph) {
        p.ph_lo = ph; p.ph_hi = ph + 1; p.coop = 0; p.pad = 0;
        hipLaunchKernelGGL(mega_fwd, dim3(grid), dim3(NWAVES * 64), LDS_BYTES, stream, p);
    }
#endif
}
```

```cpp
#include <hip/hip_runtime.h>
#include <hip/hip_cooperative_groups.h>
#include <cstdio>
#include <cstdint>
namespace cg = cooperative_groups;

#ifndef ONE_LAUNCH
#define ONE_LAUNCH 1
#endif

#ifndef REP_GEMM
#define REP_GEMM 1
#endif
#ifndef REP_ATTN
#define REP_ATTN 1
#endif
#ifndef REP_ROW
#define REP_ROW 1
#endif

#define LAS __attribute__((address_space(3)))
#define GAS __attribute__((address_space(1)))

namespace pg8 {
#define PG8_LAS __attribute__((address_space(3)))
typedef unsigned short bf16_t;
typedef short bf16x8 __attribute__((ext_vector_type(8)));
typedef float f32x4 __attribute__((ext_vector_type(4)));
typedef unsigned u32x4 __attribute__((ext_vector_type(4)));
constexpr int BM = 256, BK = 64, HALF = 128, HTB = HALF * BK * 2  , STAGE_BYTES = 8 * HTB, NXCD = 8, WGM = 8;

__host__ __device__ __forceinline__ int lds_byte(int r, int c) { const int st = (r >> 4) * 2 + (c >> 5), rr = r & 15, cc = c & 31, ob = rr * 64 + cc * 2; return st * 1024 + (ob ^ (((ob >> 9) & 1) << 5)); }
__host__ __device__ __forceinline__ void stage_rc(int b, int& R, int& C) { const int st = b / 1024, sb = b % 1024, swz = sb ^ (((sb >> 9) & 1) << 5); R = (st >> 1) * 16 + swz / 64; C = (st & 1) * 32 + (swz % 64) / 2; }
__host__ __device__ __forceinline__ int perm32(int rho) { const int n = rho >> 4, i = rho & 15; return 8 * (i >> 2) + 4 * n + (i & 3); }

struct Unit { int pm, pn; };
struct Gemm { const bf16_t* A; const bf16_t* Bt; int M, N, K, lda; };

struct StaticOrder {
    int nM, nN, nwg, G, c;
    __host__ __device__ void init(int M, int N, int G_, int c_) { nM = M / BM; nN = N / BM; nwg = nM * nN; G = G_; c = c_; }
    __host__ __device__ bool next(int i, Unit& u) const {
        const long L = (long)i * G + c; if (L >= nwg) return false;
        int wgid = (int)L; { const int q = nwg / NXCD, r = nwg % NXCD, xcd = wgid % NXCD, off = wgid / NXCD; wgid = (xcd < r ? xcd * (q + 1) : r * (q + 1) + (xcd - r) * q) + off; }
        const int nig = WGM * nN, gid = wgid / nig, fm = gid * WGM, gsz = (nM - fm) < WGM ? (nM - fm) : WGM;
        u.pm = fm + ((wgid % nig) % gsz); u.pn = (wgid % nig) / gsz; return true;
    }
    __device__ __forceinline__ void a_ready(const Unit&) const {}
    __device__ __forceinline__ void done(const Unit&) const {}
};

typedef float f32x2_t __attribute__((ext_vector_type(2)));
typedef __bf16 bf16x2_t __attribute__((ext_vector_type(2)));
__device__ __forceinline__ unsigned cvt_pk_bf16(float lo, float hi) { f32x2_t v = {lo, hi}; bf16x2_t b = __builtin_convertvector(v, bf16x2_t); return __builtin_bit_cast(unsigned, b); }
__device__ __forceinline__ float bf_lo(unsigned w) { return __uint_as_float(w << 16); }
__device__ __forceinline__ float bf_hi(unsigned w) { return __uint_as_float(w & 0xffff0000u); }
__device__ __forceinline__ float sigmoid_f(float v) { return __builtin_amdgcn_rcpf(1.0f + __builtin_amdgcn_exp2f(-1.4426950408889634f * v)); }

template <int MODE> struct Epi {
    static constexpr bool PERM = true, AFTER_DRAIN = false;
    bf16_t* O; int ldc; const float* bias; const bf16_t* G; int ldg; int accum;
    __device__ __forceinline__ void operator()(const f32x4 (&acc)[2][2][4][2], const Unit& u, int wr, int wc, int fr, int fq) const {
        const int row0 = u.pm * BM + wr * 64 + fr;
        if constexpr (MODE == 1) {
            const int col0 = u.pn * HALF + wc * 32 + 8 * fq;
#pragma unroll
            for (int ai = 0; ai < 2; ++ai)
#pragma unroll
                for (int m = 0; m < 4; ++m) {
                    bf16_t* rowp = O + (size_t)(row0 + ai * HALF + m * 16) * ldc + col0;
                    float h[8];
#pragma unroll
                    for (int n = 0; n < 2; ++n)
#pragma unroll
                        for (int e = 0; e < 4; ++e) { const float a = acc[ai][0][m][n][e], b = acc[ai][1][m][n][e]; h[n * 4 + e] = a * sigmoid_f(a) * b; }
                    u32x4 w; w.x = cvt_pk_bf16(h[0], h[1]); w.y = cvt_pk_bf16(h[2], h[3]); w.z = cvt_pk_bf16(h[4], h[5]); w.w = cvt_pk_bf16(h[6], h[7]);
                    *(u32x4*)rowp = w;
                }
        } else {
            const int col0 = u.pn * BM + wc * 32 + 8 * fq;
#pragma unroll
            for (int bj = 0; bj < 2; ++bj) {
                const int c = col0 + bj * HALF;
                f32x4 bv0 = (f32x4){0.f, 0.f, 0.f, 0.f}, bv1 = bv0;
                if constexpr (MODE == 2) { bv0 = *(const f32x4*)(bias + c); bv1 = *(const f32x4*)(bias + c + 4); }
#pragma unroll
                for (int ai = 0; ai < 2; ++ai)
#pragma unroll
                    for (int m = 0; m < 4; ++m) {
                        const size_t row = (size_t)(row0 + ai * HALF + m * 16);
                        f32x4 v0 = acc[ai][bj][m][0], v1 = acc[ai][bj][m][1];
                        if constexpr (MODE == 2) {
                            v0 = v0 + bv0; v1 = v1 + bv1;
#pragma unroll
                            for (int e = 0; e < 4; ++e) { v0[e] = sigmoid_f(v0[e]); v1[e] = sigmoid_f(v1[e]); }
                        }
                        if constexpr (MODE == 3) {
                            const u32x4 g = *(const u32x4*)(G + row * ldg + c);
                            v0[0] *= bf_lo(g.x); v0[1] *= bf_hi(g.x); v0[2] *= bf_lo(g.y); v0[3] *= bf_hi(g.y);
                            v1[0] *= bf_lo(g.z); v1[1] *= bf_hi(g.z); v1[2] *= bf_lo(g.w); v1[3] *= bf_hi(g.w);
                            if (accum) {
                                const u32x4 pv = *(const u32x4*)(O + row * ldc + c);
                                v0[0] += bf_lo(pv.x); v0[1] += bf_hi(pv.x); v0[2] += bf_lo(pv.y); v0[3] += bf_hi(pv.y);
                                v1[0] += bf_lo(pv.z); v1[1] += bf_hi(pv.z); v1[2] += bf_lo(pv.w); v1[3] += bf_hi(pv.w);
                            }
                        }
                        u32x4 w; w.x = cvt_pk_bf16(v0[0], v0[1]); w.y = cvt_pk_bf16(v0[2], v0[3]); w.z = cvt_pk_bf16(v1[0], v1[1]); w.w = cvt_pk_bf16(v1[2], v1[3]);
                        *(u32x4*)(O + row * ldc + c) = w;
                    }
            }
        }
    }
};

template <class Epi, class Sched, bool ALIGN_EPI = true>
__device__ __forceinline__ void gemm_phase(PG8_LAS unsigned char* lds, const Gemm g, const Sched& S, const Epi& E, const int tid) {
    const int wid = __builtin_amdgcn_readfirstlane(tid >> 6), lane = tid & 63, wr = wid >> 2, wc = wid & 3, fr = lane & 15, fq = lane >> 4;
    const int K = g.K, nt = K / BK, lda = g.lda;
    unsigned voffA[2], voffB[2];
#pragma unroll
    for (int i = 0; i < 2; ++i) { int R, C; stage_rc(tid * 16 + i * 8192, R, C); const int Rb = Epi::PERM ? ((R & ~31) + perm32(R & 31)) : R;
        voffA[i] = (unsigned)(R * lda + C) * 2u; voffB[i] = (unsigned)(Rb * K + C) * 2u; }
    const size_t kstep = (size_t)(BK * 2);
    const size_t hstepA = (size_t)HALF * lda * 2, hstepB = (size_t)HALF * K * 2;
    const size_t tstepA = 2 * hstepA, tstepB = 2 * hstepB;
    const unsigned ldsw = (unsigned)wid * 1024u;
    const int aoff = lds_byte(wr * 64 + fr, fq * 8), boff = lds_byte(wc * 32 + fr, fq * 8);
#define PG8_SA(b, h) (((b) * 2 + (h)) * HTB)
#define PG8_SB(b, h) ((4 + (b) * 2 + (h)) * HTB)
#define PG8_STAGE(bufoff, gbase, voff) do { _Pragma("unroll") for (int _i = 0; _i < 2; ++_i) \
        __builtin_amdgcn_global_load_lds((const unsigned*)((const char*)(gbase) + (voff)[_i]), (PG8_LAS unsigned*)(lds + (bufoff) + ldsw + _i * 8192), 16, 0, 0); } while (0)
#define PG8_LDA(dst, b, h) do { _Pragma("unroll") for (int m = 0; m < 4; ++m) _Pragma("unroll") for (int k = 0; k < 2; ++k) dst[m][k] = *(const PG8_LAS bf16x8*)(lds + PG8_SA(b, h) + aoff + m * 2048 + k * 1024); } while (0)
#define PG8_LDB(dst, b, h) do { _Pragma("unroll") for (int n = 0; n < 2; ++n) _Pragma("unroll") for (int k = 0; k < 2; ++k) dst[n][k] = *(const PG8_LAS bf16x8*)(lds + PG8_SB(b, h) + boff + n * 2048 + k * 1024); } while (0)
#define PG8_MMA(ai, bj, At, Bt) do { __builtin_amdgcn_s_setprio(1); _Pragma("unroll") for (int m = 0; m < 4; ++m) _Pragma("unroll") for (int n = 0; n < 2; ++n) _Pragma("unroll") for (int k = 0; k < 2; ++k) \
        acc[ai][bj][m][n] = __builtin_amdgcn_mfma_f32_16x16x32_bf16(Bt[n][k], At[m][k], acc[ai][bj][m][n], 0, 0, 0); __builtin_amdgcn_s_setprio(0); } while (0)
#define PG8_WAIT_V(n) asm volatile("s_waitcnt vmcnt(" #n ")" ::: "memory")
#define PG8_WAIT_L(n) asm volatile("s_waitcnt lgkmcnt(" #n ")" ::: "memory")
#define PG8_BAR __builtin_amdgcn_s_barrier()
#define PG8_SCHED __builtin_amdgcn_sched_barrier(0)
    Unit cur, nxt; int ui = 0;
    if (!S.next(0, cur)) return;
    f32x4 acc[2][2][4][2];
#pragma unroll
    for (int a = 0; a < 2; ++a)
#pragma unroll
        for (int b = 0; b < 2; ++b)
#pragma unroll
            for (int m = 0; m < 4; ++m)
#pragma unroll
                for (int n = 0; n < 2; ++n) acc[a][b][m][n] = (f32x4){0.f, 0.f, 0.f, 0.f};
    bf16x8 At[4][2], B0[2][2], B1[2][2];
    const char* cA = (const char*)g.A + (size_t)cur.pm * tstepA; const char* cB = (const char*)g.Bt + (size_t)cur.pn * tstepB;
    S.a_ready(cur);
    PG8_STAGE(PG8_SB(0, 0), cB, voffB); PG8_STAGE(PG8_SB(0, 1), cB + hstepB, voffB); PG8_STAGE(PG8_SA(0, 0), cA, voffA); PG8_STAGE(PG8_SA(0, 1), cA + hstepA, voffA);
    if (wr == 1) PG8_BAR;
    PG8_WAIT_V(2); PG8_BAR;
    PG8_STAGE(PG8_SB(1, 0), cB + kstep, voffB); PG8_STAGE(PG8_SA(1, 0), cA + kstep, voffA); PG8_STAGE(PG8_SB(1, 1), cB + hstepB + kstep, voffB);
    PG8_WAIT_V(6); PG8_BAR;
    for (;;) {
        const bool has_next = S.next(ui + 1, nxt);
        const char* nA = has_next ? (const char*)g.A + (size_t)nxt.pm * tstepA : cA; const char* nB = has_next ? (const char*)g.Bt + (size_t)nxt.pn * tstepB : cB;
        for (int t = 0; t < nt; t += 2) {
            const bool last = (t == nt - 2);
            const char* a1 = cA + (size_t)(t + 1) * kstep;
            const char* a2 = last ? nA : cA + (size_t)(t + 2) * kstep; const char* b2 = last ? nB : cB + (size_t)(t + 2) * kstep;
            const char* a3 = a2 + kstep; const char* b3 = b2 + kstep;
            if (last && has_next) S.a_ready(nxt);
            PG8_LDB(B0, 0, 0); PG8_LDB(B1, 0, 1); PG8_SCHED; PG8_LDA(At, 0, 0); PG8_STAGE(PG8_SA(1, 1), a1 + hstepA, voffA);
            PG8_WAIT_V(8); PG8_WAIT_L(0); PG8_BAR; PG8_MMA(0, 0, At, B0); PG8_MMA(0, 1, At, B1); PG8_BAR; PG8_SCHED;
            PG8_LDA(At, 0, 1); PG8_STAGE(PG8_SB(0, 0), b2, voffB); PG8_STAGE(PG8_SB(0, 1), b2 + hstepB, voffB); PG8_STAGE(PG8_SA(0, 0), a2, voffA);
            PG8_WAIT_V(8); PG8_WAIT_L(0); PG8_BAR; PG8_MMA(1, 0, At, B0); PG8_MMA(1, 1, At, B1); PG8_BAR; PG8_SCHED;
            PG8_LDB(B0, 1, 0); PG8_LDB(B1, 1, 1); PG8_SCHED; PG8_LDA(At, 1, 0); PG8_STAGE(PG8_SA(0, 1), a2 + hstepA, voffA);
            PG8_WAIT_V(8); PG8_WAIT_L(0); PG8_BAR; PG8_MMA(0, 0, At, B0); PG8_MMA(0, 1, At, B1); PG8_BAR; PG8_SCHED;
            PG8_LDA(At, 1, 1); PG8_STAGE(PG8_SB(1, 0), b3, voffB); PG8_STAGE(PG8_SB(1, 1), b3 + hstepB, voffB); PG8_STAGE(PG8_SA(1, 0), a3, voffA);
            PG8_WAIT_V(8); PG8_WAIT_L(0); PG8_BAR; PG8_MMA(1, 0, At, B0); PG8_MMA(1, 1, At, B1); PG8_BAR; PG8_SCHED;
        }
        if constexpr (ALIGN_EPI) { if (wr == 0) PG8_BAR; }
        E(acc, cur, wr, wc, fr, fq); S.done(cur);
        if (!has_next) break;
#pragma unroll
        for (int a = 0; a < 2; ++a)
#pragma unroll
            for (int b = 0; b < 2; ++b)
#pragma unroll
                for (int m = 0; m < 4; ++m)
#pragma unroll
                    for (int n = 0; n < 2; ++n) acc[a][b][m][n] = (f32x4){0.f, 0.f, 0.f, 0.f};
        cur = nxt; cA = nA; cB = nB; ++ui;
        if constexpr (ALIGN_EPI) { if (wr == 1) PG8_BAR; }
    }
    PG8_WAIT_V(0);
    if constexpr (!ALIGN_EPI) { if (wr == 0) PG8_BAR; }
    PG8_BAR;
#undef PG8_SA
#undef PG8_SB
#undef PG8_STAGE
#undef PG8_LDA
#undef PG8_LDB
#undef PG8_MMA
#undef PG8_WAIT_V
#undef PG8_WAIT_L
#undef PG8_BAR
#undef PG8_SCHED
}
}

typedef unsigned short bf16;
typedef short bf16x8 __attribute__((ext_vector_type(8)));
typedef float f32x4 __attribute__((ext_vector_type(4)));
typedef float f32x16 __attribute__((ext_vector_type(16)));
typedef unsigned v4u __attribute__((ext_vector_type(4)));
typedef unsigned v2u __attribute__((ext_vector_type(2)));

constexpr int DM = 1024, NBATCH = 4, SEQ = 8192, MTOK = NBATCH * SEQ, FFN = 2816, PIN = 2048, NGATE = 3072, MEMLEN = 256, MEMROWS = NBATCH * MEMLEN;
constexpr int NWAVES = 8;
constexpr float EPSN = 1e-6f;
constexpr float LOG2E = 1.4426950408889634f, LN2 = 0.6931471805599453f;
constexpr float C2 = 0.125f * LOG2E;

constexpr size_t MiB = (size_t)1 << 20;
constexpr size_t WS_WB = 1 * MiB, WS_KVMEM = 49 * MiB, WS_MH = 50 * MiB, WS_LSE = 52 * MiB, WS_XN = 54 * MiB, WS_R = 118 * MiB;
constexpr size_t WS_H = WS_R, WS_YF = WS_R + 176 * MiB;
constexpr size_t WS_Z = WS_R, WS_GATES = WS_R + 128 * MiB, WS_OALL = WS_R + 320 * MiB, WS_MERGED = WS_R, WS_YM = WS_R + 64 * MiB;
constexpr size_t WS_END = WS_R + 384 * MiB;
constexpr size_t WO_F1IN = 0, WO_F1OUT = 5767168, WO_WIN = 8650752, WO_WGATE = 10747904, WO_BRA = 13893632, WO_BRB = 14286848, WO_BRC = 14680064,
                 WO_WO = 14942208, WO_F2IN = 15990784, WO_F2OUT = 21757952, WO_MEMKV = 24641536;
constexpr int RING_BYTES = 131072, LUT_OFF = RING_BYTES, LUT_PITCH = 132, MISC_OFF = 139264, LDS_BYTES = 147456;
constexpr size_t WS_CTL = 0, CTL_ZERO_BYTES = 65536;

struct Params { const float* in[18]; float* out; unsigned char* ws; int ph_lo, ph_hi, coop, pad; };

#define LDS_WAIT() asm volatile("s_waitcnt lgkmcnt(0)" ::: "memory")
__device__ __forceinline__ unsigned pk2(float lo, float hi) { return pg8::cvt_pk_bf16(lo, hi); }
__device__ __forceinline__ float wave_sum(float v) {
#pragma unroll
    for (int o = 1; o < 64; o <<= 1) v += __shfl_xor(v, o);
    return v;
}

__device__ __forceinline__ void transpose_item(const float* W, int K, int N, bf16* WT, int k0, int n0, int rowbase, LAS float* scr, int lane) {
#pragma unroll 8
    for (int i = 0; i < 32; ++i) { const int kk = 2 * i + (lane >> 5); scr[kk * 33 + (lane & 31)] = W[(size_t)(k0 + kk) * N + n0 + (lane & 31)]; }
    LDS_WAIT(); asm volatile("" ::: "memory");
    const int c = lane & 7;
#pragma unroll
    for (int j = 0; j < 4; ++j) { const int n = (lane >> 3) + 8 * j; const LAS float* s = scr + (8 * c) * 33 + n;
        v4u o; o.x = pk2(s[0 * 33], s[1 * 33]); o.y = pk2(s[2 * 33], s[3 * 33]); o.z = pk2(s[4 * 33], s[5 * 33]); o.w = pk2(s[6 * 33], s[7 * 33]);
        *(v4u*)(WT + (size_t)(rowbase + n) * K + k0 + 8 * c) = o; }
    LDS_WAIT(); asm volatile("" ::: "memory");
}
__device__ __forceinline__ void tr_plain(const float* W, int K, int N, bf16* WT, int r, LAS float* scr, int lane) {
    const int nblk = N / 32, kb = r / nblk, nb = r % nblk;
    transpose_item(W, K, N, WT, 64 * kb, 32 * nb, 32 * nb, scr, lane);
}
__device__ __forceinline__ void tr_ffnin(const float* W, bf16* WT, int r, LAS float* scr, int lane) {
    const int nblk = (2 * FFN) / 32, kb = r / nblk, nb = r % nblk, n0 = 32 * nb;
    const int isb = n0 >= FFN ? 1 : 0, j = n0 - isb * FFN;
    const int rowbase = (j >> 7) * 256 + isb * 128 + (j & 127);
    transpose_item(W, DM, 2 * FFN, WT, 64 * kb, n0, rowbase, scr, lane);
}

__device__ __forceinline__ void convert_weights(const Params& p, int l, bf16* WB, LAS unsigned char* lds, int gw, int ngw, int wave, int lane) {
    LAS float* scr = (LAS float*)(lds + wave * 16384);
    constexpr int I_FIN = 16 * 176, I_FOUT = 44 * 32, I_WIN = 16 * 64, I_WG = 16 * 96, I_BRA = 6 * 32, I_BRC = 4 * 32, I_WO = 16 * 32, I_MKV = 16 * 16;
    constexpr int NITEMS = 2 * I_FIN + 2 * I_FOUT + I_WIN + I_WG + 2 * I_BRA + I_BRC + I_WO + I_MKV;
    const float* f1in = p.in[5] + (size_t)l * DM * 2 * FFN; const float* f1out = p.in[6] + (size_t)l * FFN * DM;
    const float* win = p.in[7] + (size_t)l * DM * PIN; const float* wmkv = p.in[9] + (size_t)l * DM * 512;
    const float* wgate = p.in[10] + (size_t)l * DM * NGATE;
    const float* bra = p.in[12] + (size_t)l * 384 * DM; const float* brb = p.in[13] + (size_t)l * 384 * DM; const float* brc = p.in[14] + (size_t)l * 256 * DM;
    const float* wo = p.in[15] + (size_t)l * DM * DM; const float* f2in = p.in[16] + (size_t)l * DM * 2 * FFN; const float* f2out = p.in[17] + (size_t)l * FFN * DM;
    for (int it = gw; it < NITEMS; it += ngw) {
        int r = it;
        if (r < I_FIN) { tr_ffnin(f1in, WB + WO_F1IN, r, scr, lane); continue; } r -= I_FIN;
        if (r < I_FIN) { tr_ffnin(f2in, WB + WO_F2IN, r, scr, lane); continue; } r -= I_FIN;
        if (r < I_FOUT) { tr_plain(f1out, FFN, DM, WB + WO_F1OUT, r, scr, lane); continue; } r -= I_FOUT;
        if (r < I_FOUT) { tr_plain(f2out, FFN, DM, WB + WO_F2OUT, r, scr, lane); continue; } r -= I_FOUT;
        if (r < I_WIN) { tr_plain(win, DM, PIN, WB + WO_WIN, r, scr, lane); continue; } r -= I_WIN;
        if (r < I_WG) { tr_plain(wgate, DM, NGATE, WB + WO_WGATE, r, scr, lane); continue; } r -= I_WG;
        if (r < I_BRA) { tr_plain(bra, 384, DM, WB + WO_BRA, r, scr, lane); continue; } r -= I_BRA;
        if (r < I_BRA) { tr_plain(brb, 384, DM, WB + WO_BRB, r, scr, lane); continue; } r -= I_BRA;
        if (r < I_BRC) { tr_plain(brc, 256, DM, WB + WO_BRC, r, scr, lane); continue; } r -= I_BRC;
        if (r < I_WO) { tr_plain(wo, DM, DM, WB + WO_WO, r, scr, lane); continue; } r -= I_WO;
        tr_plain(wmkv, DM, 512, WB + WO_MEMKV, r, scr, lane);
    }
}

__device__ __forceinline__ void row_pass(const float* xin, const bf16* y, const float* gpost, float scale, float* xout, const float* gpre, bf16* xn, int lane) {
    const f32x4* xr = (const f32x4*)xin + lane;
    f32x4 v[4];
#pragma unroll
    for (int j = 0; j < 4; ++j) v[j] = xr[64 * j];
    if (y) {
        const v2u* yr = (const v2u*)y + lane;
        f32x4 yv[4]; float ss = 0.f;
#pragma unroll
        for (int j = 0; j < 4; ++j) { const v2u w = yr[64 * j]; yv[j] = (f32x4){pg8::bf_lo(w.x), pg8::bf_hi(w.x), pg8::bf_lo(w.y), pg8::bf_hi(w.y)};
            ss += (yv[j].x * yv[j].x + yv[j].y * yv[j].y) + (yv[j].z * yv[j].z + yv[j].w * yv[j].w); }
        const float rs = scale / sqrtf(wave_sum(ss) * (1.f / DM) + EPSN);
#pragma unroll
        for (int j = 0; j < 4; ++j) { const f32x4 g = ((const f32x4*)gpost)[lane + 64 * j]; v[j] = v[j] + yv[j] * g * rs; }
    }
    if (xout) {
        f32x4* xo = (f32x4*)xout + lane;
#pragma unroll
        for (int j = 0; j < 4; ++j) xo[64 * j] = v[j];
    }
    if (xn) {
        float s2 = 0.f;
#pragma unroll
        for (int j = 0; j < 4; ++j) s2 += (v[j].x * v[j].x + v[j].y * v[j].y) + (v[j].z * v[j].z + v[j].w * v[j].w);
        const float rstd = 1.f / sqrtf(wave_sum(s2) * (1.f / DM) + EPSN);
        v2u* o8 = (v2u*)xn + lane;
#pragma unroll
        for (int j = 0; j < 4; ++j) { const f32x4 g = ((const f32x4*)gpre)[lane + 64 * j]; const f32x4 t = v[j] * g * rstd;
            v2u w; w.x = pk2(t.x, t.y); w.y = pk2(t.z, t.w); o8[64 * j] = w; }
    }
}

__device__ __forceinline__ int crow(int r, int hi) { return (r & 3) + 8 * (r >> 2) + 4 * hi; }
#define MFMA32(a, b, c) __builtin_amdgcn_mfma_f32_32x32x16_bf16((a), (b), (c), 0, 0, 0)

template <bool MASKED>
__device__ __forceinline__ void attn_wave(const bf16* qp, long qstep, const bf16* kp, long kstep, const bf16* vp, long vstep, bf16* op, long ostep,
                                          float* lsep, long lsestep, int i0, int t_lo, int t_hi, int maxd, const LAS float* lut, float m0, float l0, int lane) {
    const int q = lane & 31, hi = lane >> 5, qi = i0 + q;
    bf16x8 qf[4];
    { const bf16* qrow = qp + (long)qi * qstep + 8 * hi;
#pragma unroll
      for (int d0 = 0; d0 < 4; ++d0) qf[d0] = *(const bf16x8*)(qrow + 16 * d0); }
    float m = m0, l = (hi == 0) ? l0 : 0.f;
    f32x16 o0, o1;
#pragma unroll
    for (int r = 0; r < 16; ++r) { o0[r] = 0.f; o1[r] = 0.f; }
    for (int t = t_lo; t <= t_hi; ++t) {
        const int kv0 = 32 * t;
        bf16x8 kf[4];
        { const bf16* krow = kp + (long)(kv0 + q) * kstep + 8 * hi;
#pragma unroll
          for (int d0 = 0; d0 < 4; ++d0) kf[d0] = *(const bf16x8*)(krow + 16 * d0); }
        f32x16 p;
#pragma unroll
        for (int r = 0; r < 16; ++r) p[r] = 0.f;
#pragma unroll
        for (int d0 = 0; d0 < 4; ++d0) p = MFMA32(kf[d0], qf[d0], p);
        float tmax = -INFINITY;
#pragma unroll
        for (int r = 0; r < 16; ++r) {
            float s = p[r] * C2;
            if (MASKED) {
                const int dist = qi - (kv0 + crow(r, hi));
                const bool ok = (dist >= 0) && (dist <= maxd);
                const int di = dist < 0 ? 0 : (dist > 128 ? 128 : dist);
                s += lut[di];
                s = ok ? s : -INFINITY;
            }
            p[r] = s; tmax = fmaxf(tmax, s);
        }
        tmax = fmaxf(tmax, __shfl_xor(tmax, 32));
        const float mn = fmaxf(m, tmax);
        const float sc = __builtin_amdgcn_exp2f(m - mn);
        m = mn; l *= sc;
#pragma unroll
        for (int r = 0; r < 16; ++r) { o0[r] *= sc; o1[r] *= sc; }
        float ps = 0.f;
#pragma unroll
        for (int r = 0; r < 16; ++r) { const float e = __builtin_amdgcn_exp2f(p[r] - mn); p[r] = e; ps += e; }
        l += ps;
        v4u pw0, pw1;
        pw0.x = pk2(p[0], p[1]); pw0.y = pk2(p[2], p[3]); pw0.z = pk2(p[4], p[5]); pw0.w = pk2(p[6], p[7]);
        pw1.x = pk2(p[8], p[9]); pw1.y = pk2(p[10], p[11]); pw1.z = pk2(p[12], p[13]); pw1.w = pk2(p[14], p[15]);
        const bf16x8 pb0 = __builtin_bit_cast(bf16x8, pw0), pb1 = __builtin_bit_cast(bf16x8, pw1);
#pragma unroll
        for (int s = 0; s < 2; ++s) {
#pragma unroll
            for (int db = 0; db < 2; ++db) {
                bf16x8 va;
#pragma unroll
                for (int j = 0; j < 8; ++j) { const int kk = kv0 + 16 * s + 8 * (j >> 2) + 4 * hi + (j & 3); va[j] = (short)vp[(long)kk * vstep + 32 * db + q]; }
                if (db == 0) o0 = MFMA32(va, s == 0 ? pb0 : pb1, o0); else o1 = MFMA32(va, s == 0 ? pb0 : pb1, o1);
            }
        }
    }
    l += __shfl_xor(l, 32);
    const float inv = 1.f / l;
    bf16* orow = op + (long)qi * ostep + 4 * hi;
#pragma unroll
    for (int g = 0; g < 4; ++g) {
        v2u w0, w1;
        w0.x = pk2(o0[4 * g] * inv, o0[4 * g + 1] * inv); w0.y = pk2(o0[4 * g + 2] * inv, o0[4 * g + 3] * inv);
        w1.x = pk2(o1[4 * g] * inv, o1[4 * g + 1] * inv); w1.y = pk2(o1[4 * g + 2] * inv, o1[4 * g + 3] * inv);
        *(v2u*)(orow + 8 * g) = w0; *(v2u*)(orow + 32 + 8 * g) = w1;
    }
    if (lsep && hi == 0) lsep[(long)qi * lsestep] = m * LN2 + logf(l);
}

#define XB_TMO      128
#define XB_XCNT(j)  (256  + 64 * (j))
#define XB_XSUB(j)  (1280 + 64 * (j))
#define XB_XGEN(j)  (2304 + 64 * (j))
#define XB_TOP      3328
#define XB_TOPGEN   3392
#define XCD_BAR_WORDS 3456
#define XB_SPIN_CAP (1u << 18)

__device__ __forceinline__ unsigned xb_ld(unsigned* p)              { return __hip_atomic_load(p, __ATOMIC_RELAXED, __HIP_MEMORY_SCOPE_AGENT); }
__device__ __forceinline__ unsigned xb_add(unsigned* p, unsigned v) { return __hip_atomic_fetch_add(p, v, __ATOMIC_RELAXED, __HIP_MEMORY_SCOPE_AGENT); }
__device__ __forceinline__ unsigned xb_xcc_id() { return (unsigned)__builtin_amdgcn_s_getreg((3 << 11) | 20) & 0xFu; }
#define XB_SPIN(cond, bar) do { unsigned _sp = 0; while (cond) { __builtin_amdgcn_s_sleep(1); \
    if ((++_sp & 255u) == 0u) { if (xb_ld(&(bar)[XB_TMO])) break; if (_sp > XB_SPIN_CAP) { atomicAdd(&(bar)[XB_TMO], 1u); break; } } } } while (0)

struct XcdBarrier {
    unsigned* bar; unsigned x;
    volatile LAS unsigned* st;
};

__device__ __forceinline__ XcdBarrier xcd_barrier_post(unsigned* bar, volatile LAS unsigned* st) {
    XcdBarrier b; b.bar = bar; b.x = xb_xcc_id(); b.st = st;
    if (threadIdx.x == 0) (void)xb_add(&bar[XB_XCNT(b.x)], 1u);
    return b;
}
__device__ __forceinline__ void xcd_barrier_complete(unsigned* bar, unsigned x, unsigned& nloc, unsigned& nx) {
    const unsigned G = gridDim.x * gridDim.y * gridDim.z;
    unsigned sum, cnt, mine, sp = 0u;
    for (;;) {
        sum = 0u; cnt = 0u; mine = 0u;
#pragma unroll
        for (unsigned j = 0; j < 16; ++j) { const unsigned c = xb_ld(&bar[XB_XCNT(j)]); sum += c; cnt += (c > 0u) ? 1u : 0u; mine = (j == x) ? c : mine; }
        if (sum == G) break;
        __builtin_amdgcn_s_sleep(1);
        if ((++sp & 255u) == 0u) { if (xb_ld(&bar[XB_TMO])) break; if (sp > XB_SPIN_CAP) { atomicAdd(&bar[XB_TMO], 1u); break; } }
    }
    nloc = mine > 0u ? mine : 1u; nx = cnt > 0u ? cnt : 1u;
}

__device__ __forceinline__ void xcd_barrier(const XcdBarrier& b) {
    asm volatile("s_waitcnt vmcnt(0)" ::: "memory");
    __syncthreads();
    if (threadIdx.x == 0) {
        unsigned* bar = b.bar;
        __builtin_amdgcn_s_waitcnt(0);
        unsigned nloc = b.st[0], nx = b.st[1];
        if (nloc == 0u) { xcd_barrier_complete(bar, b.x, nloc, nx); b.st[0] = nloc; b.st[1] = nx; }
        const unsigned old = xb_add(&bar[XB_XSUB(b.x)], 1u);
        const unsigned gen = old / nloc;
        if (old + 1u == (gen + 1u) * nloc) {
            __builtin_amdgcn_fence(__ATOMIC_RELEASE, "agent");
            asm volatile("s_waitcnt vmcnt(0)" ::: "memory");
            const unsigned og = xb_add(&bar[XB_TOP], 1u);
            const unsigned tg = og / nx;
            if (og + 1u == (tg + 1u) * nx) xb_add(&bar[XB_TOPGEN], 1u);
            else XB_SPIN(xb_ld(&bar[XB_TOPGEN]) == tg, bar);
            __builtin_amdgcn_fence(__ATOMIC_ACQUIRE, "agent");
            xb_add(&bar[XB_XGEN(b.x)], 1u);
            asm volatile("s_waitcnt vmcnt(0)" ::: "memory");
        } else {
            XB_SPIN(xb_ld(&bar[XB_XGEN(b.x)]) == gen, bar);
            __builtin_amdgcn_fence(__ATOMIC_ACQUIRE, "agent");
            asm volatile("s_waitcnt vmcnt(0)" ::: "memory");
        }
    }
    __syncthreads();
}

struct Job { int mode; const bf16* A; int lda; const bf16* Bt; int M, N, K; bf16* O; int ldc; const float* bias; const bf16* G; int ldg; int accum; };

__device__ __forceinline__ void run_job(const Job& J, LAS unsigned char* lds, int G, int bid, int tid) {
    pg8::Gemm g{J.A, J.Bt, J.M, J.N, J.K, J.lda};
    pg8::StaticOrder S; S.init(J.M, J.N, G, bid);
    if (J.mode == 0) { pg8::Epi<0> E{J.O, J.ldc, J.bias, J.G, J.ldg, J.accum}; pg8::gemm_phase<pg8::Epi<0>, pg8::StaticOrder, true>(lds, g, S, E, tid); }
    else if (J.mode == 1) { pg8::Epi<1> E{J.O, J.ldc, J.bias, J.G, J.ldg, J.accum}; pg8::gemm_phase<pg8::Epi<1>, pg8::StaticOrder, true>(lds, g, S, E, tid); }
    else if (J.mode == 2) { pg8::Epi<2> E{J.O, J.ldc, J.bias, J.G, J.ldg, J.accum}; pg8::gemm_phase<pg8::Epi<2>, pg8::StaticOrder, true>(lds, g, S, E, tid); }
    else { pg8::Epi<3> E{J.O, J.ldc, J.bias, J.G, J.ldg, J.accum}; pg8::gemm_phase<pg8::Epi<3>, pg8::StaticOrder, true>(lds, g, S, E, tid); }
}

__global__ void __launch_bounds__(NWAVES * 64, 2) mega_fwd(Params p) {
    extern __shared__ __attribute__((aligned(16))) unsigned char lds_raw[];
    LAS unsigned char* lds = (LAS unsigned char*)lds_raw;
    const int G = gridDim.x, bid = blockIdx.x;
    LAS float* lut = (LAS float*)(lds + LUT_OFF);
    const float* rel_bias = p.in[2];
    const int tid = threadIdx.x;

    for (int i = tid; i < 12 * 129; i += NWAVES * 64) {
        const int h = i / 129, dist = i % 129;
        const int rate = h < 8 ? 1 : (h < 10 ? 4 : 16);
        const int d = dist * rate;
        int bucket;
        if (d < 16) bucket = d;
        else { const float fd = (float)d; int large = 16 + (int)(logf(fd / 16.0f) / 4.852030263919617f * 16.0f); bucket = large < 31 ? large : 31; }
        lut[h * LUT_PITCH + dist] = rel_bias[bucket * 12 + h] * LOG2E;
    }
    if (tid < 32) ((LAS unsigned*)(lds + MISC_OFF))[tid] = 0u;
    __syncthreads();

    cg::grid_group grid = cg::this_grid();
    XcdBarrier bar; bar.bar = (unsigned*)(p.ws + WS_CTL); bar.x = 0; bar.st = nullptr;
    if (p.coop) bar = xcd_barrier_post((unsigned*)(p.ws + WS_CTL), (volatile LAS unsigned*)(lds + MISC_OFF) + 8);
    for (int ph = p.ph_lo; ph < p.ph_hi; ++ph) {
        int tidv = threadIdx.x; asm volatile("" : "+v"(tidv));
        const int lane = tidv & 63, wave = __builtin_amdgcn_readfirstlane(tidv >> 6);
        const int gw = bid * NWAVES + wave, ngw = G * NWAVES;
        unsigned char* ws = p.ws; asm volatile("" : "+s"(ws));
        float* out = p.out; asm volatile("" : "+s"(out));
        bf16* WB = (bf16*)(ws + WS_WB); bf16* KVMEM = (bf16*)(ws + WS_KVMEM); bf16* MH = (bf16*)(ws + WS_MH); float* LSE = (float*)(ws + WS_LSE);
        bf16* XN = (bf16*)(ws + WS_XN); bf16* H = (bf16*)(ws + WS_H); bf16* YF = (bf16*)(ws + WS_YF); bf16* Z = (bf16*)(ws + WS_Z);
        bf16* OBT = (bf16*)(ws + WS_XN);
        bf16* GATES = (bf16*)(ws + WS_GATES); bf16* OALL = (bf16*)(ws + WS_OALL); bf16* MERGED = (bf16*)(ws + WS_MERGED); bf16* YM = (bf16*)(ws + WS_YM);
        const float* x_in = p.in[0]; const float* mem = p.in[1]; const float* norm_gain = p.in[3]; const float* mem_gain = p.in[4];
        const float* sinks = p.in[8]; const float* b_gate = p.in[11];
        if (ph == 0) {
            convert_weights(p, 0, WB, lds, gw, ngw, wave, lane);
            for (int m = gw; m < MEMROWS; m += ngw) row_pass(mem + (size_t)m * DM, nullptr, nullptr, 0.f, nullptr, mem_gain, MH + (size_t)m * DM, lane);
            for (int m = gw; m < MTOK; m += ngw) row_pass(x_in + (size_t)m * DM, nullptr, nullptr, 0.f, nullptr, norm_gain, XN + (size_t)m * DM, lane);
        } else {
            const int l = (ph - 1) / 12, lp = (ph - 1) % 12;
            const float* gn = norm_gain + (size_t)l * 6 * DM;
            if (lp == 0 || lp == 1 || lp == 2 || lp == 3 || lp == 6 || lp == 7 || lp == 9 || lp == 10) {
                const int njobs = (lp == 3) ? 2 : (lp == 6 ? 3 : 1);
                for (int rep = 0; rep < REP_GEMM; ++rep)
                for (int j = 0; j < njobs; ++j) {
                    Job J; J.bias = nullptr; J.G = nullptr; J.ldg = 0; J.accum = 0; J.M = MTOK;
                    if (lp == 0 || lp == 9) { J.mode = 1; J.A = XN; J.lda = DM; J.K = DM; J.Bt = WB + (lp == 0 ? WO_F1IN : WO_F2IN); J.N = 2 * FFN; J.O = H; J.ldc = FFN; }
                    else if (lp == 1 || lp == 10) { J.mode = 0; J.A = H; J.lda = FFN; J.K = FFN; J.Bt = WB + (lp == 1 ? WO_F1OUT : WO_F2OUT); J.N = DM; J.O = YF; J.ldc = DM; }
                    else if (lp == 2) { J.mode = 0; J.A = MH; J.lda = DM; J.K = DM; J.Bt = WB + WO_MEMKV; J.M = MEMROWS; J.N = 512; J.O = KVMEM; J.ldc = 512; }
                    else if (lp == 3) {
                        if (j == 0) { J.mode = 0; J.A = XN; J.lda = DM; J.K = DM; J.Bt = WB + WO_WIN; J.N = PIN; J.O = Z; J.ldc = PIN; }
                        else { J.mode = 2; J.A = XN; J.lda = DM; J.K = DM; J.Bt = WB + WO_WGATE; J.N = NGATE; J.O = GATES; J.ldc = NGATE; J.bias = b_gate + (size_t)l * NGATE; }
                    }
                    else if (lp == 6) {
                        J.mode = 3; J.lda = DM; J.N = DM; J.O = MERGED; J.ldc = DM; J.ldg = NGATE; J.accum = j > 0 ? 1 : 0;
                        if (j == 0) { J.A = OALL; J.K = 384; J.Bt = WB + WO_BRA; J.G = GATES; }
                        else if (j == 1) { J.A = OALL + 384; J.K = 384; J.Bt = WB + WO_BRB; J.G = GATES + DM; }
                        else { J.A = OALL + 768; J.K = 256; J.Bt = WB + WO_BRC; J.G = GATES + 2 * DM; }
                    }
                    else { J.mode = 0; J.A = MERGED; J.lda = DM; J.K = DM; J.Bt = WB + WO_WO; J.N = DM; J.O = YM; J.ldc = DM; }
                    run_job(J, lds, G, bid, tidv);
                }
            }
            if (lp == 2) {
                const float* xin = (l == 0) ? x_in : out;
                for (int rep = 0; rep < REP_ROW; ++rep)
                for (int m = gw; m < MTOK; m += ngw) row_pass(xin + (size_t)m * DM, YF + (size_t)m * DM, gn + 1 * DM, rep == REP_ROW - 1 ? 0.5f : 0.f, out + (size_t)m * DM, gn + 2 * DM, XN + (size_t)m * DM, lane);
            } else if (lp == 4) {
                for (int rep = 0; rep < REP_ATTN; ++rep)
                for (int tk = gw; tk < 6144; tk += ngw) {
                    const int sl = tk & 255, b = (tk >> 8) & 3, hd = tk >> 10;
                    const int gi = hd >> 1, sh = 2 * gi;
                    const int spr = 256 >> sh;
                    const int rho = sl / spr, i0 = 32 * (sl % spr);
                    const long row0 = (long)b * SEQ + rho, st = 1L << sh;
                    const int t_hi = i0 >> 5, t_lo = t_hi >= 4 ? t_hi - 4 : 0;
                    attn_wave<true>(Z + row0 * PIN + 640 + hd * 64, st * PIN, Z + row0 * PIN + 1024 + hd * 64, st * PIN, Z + row0 * PIN + 1408 + hd * 64, st * PIN,
                                    OBT + row0 * 384 + hd * 64, st * 384, LSE + row0 * 6 + hd, st * 6, i0, t_lo, t_hi, 128, lut + (6 + hd) * LUT_PITCH, -1e30f, 0.f, lane);
                }
            } else if (lp == 5) {
                for (int rep = 0; rep < REP_ATTN; ++rep) {
                for (int tk = gw; tk < 6144; tk += ngw) {
                    const int sl = tk & 255, bh = tk >> 8, b = bh / 6, h = bh % 6, kvh = h / 3;
                    const int i0 = 32 * sl; const long row0 = (long)b * SEQ;
                    const int t_hi = sl, t_lo = t_hi >= 4 ? t_hi - 4 : 0;
                    attn_wave<true>(Z + row0 * PIN + h * 64, PIN, Z + row0 * PIN + 384 + kvh * 64, PIN, Z + row0 * PIN + 512 + kvh * 64, PIN,
                                    OALL + row0 * DM + h * 64, DM, nullptr, 0, i0, t_lo, t_hi, 127, lut + h * LUT_PITCH, sinks[l * 6 + h] * LOG2E, 1.f, lane);
                }
                for (int tk = gw; tk < 4096; tk += ngw) {
                    const int sl = tk & 255, bh = tk >> 8, b = bh >> 2, h = bh & 3;
                    const long row0 = (long)b * SEQ;
                    attn_wave<false>(Z + row0 * PIN + 1792 + h * 64, PIN, KVMEM + (long)b * MEMLEN * 512 + h * 64, 512, KVMEM + (long)b * MEMLEN * 512 + 256 + h * 64, 512,
                                     OALL + row0 * DM + 768 + h * 64, DM, nullptr, 0, 32 * sl, 0, 7, 0, lut, -1e30f, 0.f, lane);
                }
                for (int idx = bid * (NWAVES * 64) + tidv; idx < MTOK * 48; idx += G * NWAVES * 64) {
                    const int t = idx / 48, c = idx % 48, head = c >> 3, hg = head & 1;
                    const float* ls = LSE + (size_t)t * 6;
                    const float a0 = ls[hg], a1 = ls[2 + hg], a2 = ls[4 + hg], mine = ls[head];
                    const float mx = fmaxf(a0, fmaxf(a1, a2));
                    const float den = __expf(a0 - mx) + __expf(a1 - mx) + __expf(a2 - mx);
                    const float alpha = __expf(mine - mx) / den;
                    v4u* pp = (v4u*)(OALL + (size_t)t * DM + 384 + c * 8);
                    const v4u w = *(const v4u*)(OBT + (size_t)t * 384 + c * 8); v4u o;
                    o.x = pk2(pg8::bf_lo(w.x) * alpha, pg8::bf_hi(w.x) * alpha); o.y = pk2(pg8::bf_lo(w.y) * alpha, pg8::bf_hi(w.y) * alpha);
                    o.z = pk2(pg8::bf_lo(w.z) * alpha, pg8::bf_hi(w.z) * alpha); o.w = pk2(pg8::bf_lo(w.w) * alpha, pg8::bf_hi(w.w) * alpha);
                    *pp = o;
                }
                }
            } else if (lp == 8) {
                for (int rep = 0; rep < REP_ROW; ++rep)
                for (int m = gw; m < MTOK; m += ngw) row_pass(out + (size_t)m * DM, YM + (size_t)m * DM, gn + 3 * DM, rep == REP_ROW - 1 ? 1.0f : 0.f, out + (size_t)m * DM, gn + 4 * DM, XN + (size_t)m * DM, lane);
            } else if (lp == 11) {
                const bool more = (l == 0);
                for (int rep = 0; rep < REP_ROW; ++rep)
                for (int m = gw; m < MTOK; m += ngw) row_pass(out + (size_t)m * DM, YF + (size_t)m * DM, gn + 5 * DM, rep == REP_ROW - 1 ? 0.5f : 0.f, out + (size_t)m * DM,
                                                                more ? norm_gain + 6 * DM : nullptr, more ? XN + (size_t)m * DM : nullptr, lane);
                if (more) {
                    convert_weights(p, 1, WB, lds, gw, ngw, wave, lane);
                    for (int m = gw; m < MEMROWS; m += ngw) row_pass(mem + (size_t)m * DM, nullptr, nullptr, 0.f, nullptr, mem_gain + DM, MH + (size_t)m * DM, lane);
                }
            }
        }
        if (p.coop && ph + 1 < p.ph_hi) {
            if (ph == p.ph_lo) grid.sync();
            else xcd_barrier(bar);
        } else __syncthreads();
    }
}

constexpr int N_PHASES = 25;
extern "C" void kernel_launch(void* const* d_in, const int* in_sizes, int n_in, void* d_out, int out_size, void* d_ws, size_t ws_size, hipStream_t stream) {
    static int grid = 0;
    if (grid == 0) {
        if (n_in != 18 || in_sizes[0] != MTOK * DM || out_size != MTOK * DM || ws_size < WS_END) {
            fprintf(stderr, "kernel_launch: unexpected shapes (n_in %d, in0 %d, out %d, ws %zu < %zu); nothing launched\n", n_in, n_in > 0 ? in_sizes[0] : -1, out_size, ws_size, (size_t)WS_END);
            grid = -1; return; }
        int dev = 0, cus = 0, per_cu = 0;
        if (hipGetDevice(&dev) != hipSuccess || hipDeviceGetAttribute(&cus, hipDeviceAttributeMultiprocessorCount, dev) != hipSuccess) { grid = -1; return; }
        if (hipFuncSetAttribute((const void*)mega_fwd, hipFuncAttributeMaxDynamicSharedMemorySize, LDS_BYTES) != hipSuccess) { fprintf(stderr, "kernel_launch: hipFuncSetAttribute failed\n"); grid = -1; return; }
        if (hipOccupancyMaxActiveBlocksPerMultiprocessor(&per_cu, (const void*)mega_fwd, NWAVES * 64, LDS_BYTES) != hipSuccess || per_cu < 1) { fprintf(stderr, "kernel_launch: occupancy query reports %d\n", per_cu); per_cu = 1; }
        (void)hipGetLastError();
        grid = cus;
        if (grid != 256) fprintf(stderr, "kernel_launch: note: %d CUs\n", grid);
    }
    if (grid < 0) return;
    Params p{};
    for (int i = 0; i < 18; ++i) p.in[i] = (const float*)d_in[i];
    p.out = (float*)d_out; p.ws = (unsigned char*)d_ws;
#if ONE_LAUNCH
    if (hipMemsetAsync((char*)d_ws + WS_CTL, 0, CTL_ZERO_BYTES, stream) != hipSuccess) { fprintf(stderr, "kernel_launch: memset failed\n"); return; }
    p.ph_lo = 0; p.ph_hi = N_PHASES; p.coop = 1; p.pad = 0;
    void* args[] = {&p};
    hipError_t e = hipLaunchCooperativeKernel((const void*)mega_fwd, dim3(grid), dim3(NWAVES * 64), args, LDS_BYTES, stream);
    if (e != hipSuccess) fprintf(stderr, "cooperative launch failed: %s (grid %d)\n", hipGetErrorString(e), grid);
#else
    for (int ph = 0; ph < N_PHASES; ++ph) {
        p.ph_lo = ph; p.ph_hi = ph + 1; p.coop = 0; p.pad = 0;
        hipLaunchKernelGGL(mega_fwd, dim3(grid), dim3(NWAVES * 64), LDS_BYTES, stream, p);
    }
#endif
}
```

```cpp
#include <hip/hip_runtime.h>
#include <hip/hip_cooperative_groups.h>
#include <cstdio>
#include <cstdint>
namespace cg = cooperative_groups;

#ifndef ONE_LAUNCH
#define ONE_LAUNCH 1
#endif

#ifndef REP_GEMM
#define REP_GEMM 1
#endif
#ifndef REP_ATTN
#define REP_ATTN 1
#endif
#ifndef REP_ROW
#define REP_ROW 1
#endif

#define LAS __attribute__((address_space(3)))
#define GAS __attribute__((address_space(1)))

namespace pg8 {
#define PG8_LAS __attribute__((address_space(3)))
typedef unsigned short bf16_t;
typedef short bf16x8 __attribute__((ext_vector_type(8)));
typedef float f32x4 __attribute__((ext_vector_type(4)));
typedef unsigned u32x4 __attribute__((ext_vector_type(4)));
constexpr int BM = 256, BK = 64, HALF = 128, HTB = HALF * BK * 2  , STAGE_BYTES = 8 * HTB, NXCD = 8, WGM = 8;

__host__ __device__ __forceinline__ int lds_byte(int r, int c) { const int st = (r >> 4) * 2 + (c >> 5), rr = r & 15, cc = c & 31, ob = rr * 64 + cc * 2; return st * 1024 + (ob ^ (((ob >> 9) & 1) << 5)); }
__host__ __device__ __forceinline__ void stage_rc(int b, int& R, int& C) { const int st = b / 1024, sb = b % 1024, swz = sb ^ (((sb >> 9) & 1) << 5); R = (st >> 1) * 16 + swz / 64; C = (st & 1) * 32 + (swz % 64) / 2; }
__host__ __device__ __forceinline__ int perm32(int rho) { const int n = rho >> 4, i = rho & 15; return 8 * (i >> 2) + 4 * n + (i & 3); }

struct Unit { int pm, pn; };
struct Gemm { const bf16_t* A; const bf16_t* Bt; int M, N, K, lda; };

struct StaticOrder {
    int nM, nN, nwg, G, c;
    __host__ __device__ void init(int M, int N, int G_, int c_) { nM = M / BM; nN = N / BM; nwg = nM * nN; G = G_; c = c_; }
    __host__ __device__ bool next(int i, Unit& u) const {
        const long L = (long)i * G + c; if (L >= nwg) return false;
        int wgid = (int)L; { const int q = nwg / NXCD, r = nwg % NXCD, xcd = wgid % NXCD, off = wgid / NXCD; wgid = (xcd < r ? xcd * (q + 1) : r * (q + 1) + (xcd - r) * q) + off; }
        const int nig = WGM * nN, gid = wgid / nig, fm = gid * WGM, gsz = (nM - fm) < WGM ? (nM - fm) : WGM;
        u.pm = fm + ((wgid % nig) % gsz); u.pn = (wgid % nig) / gsz; return true;
    }
    __device__ __forceinline__ void a_ready(const Unit&) const {}
    __device__ __forceinline__ void done(const Unit&) const {}
};

typedef float f32x2_t __attribute__((ext_vector_type(2)));
typedef __bf16 bf16x2_t __attribute__((ext_vector_type(2)));
__device__ __forceinline__ unsigned cvt_pk_bf16(float lo, float hi) { f32x2_t v = {lo, hi}; bf16x2_t b = __builtin_convertvector(v, bf16x2_t); return __builtin_bit_cast(unsigned, b); }
__device__ __forceinline__ float bf_lo(unsigned w) { return __uint_as_float(w << 16); }
__device__ __forceinline__ float bf_hi(unsigned w) { return __uint_as_float(w & 0xffff0000u); }
__device__ __forceinline__ float sigmoid_f(float v) { return __builtin_amdgcn_rcpf(1.0f + __builtin_amdgcn_exp2f(-1.4426950408889634f * v)); }

template <int MODE> struct Epi {
    static constexpr bool PERM = true, AFTER_DRAIN = false;
    bf16_t* O; int ldc; const float* bias; const bf16_t* G; int ldg; int accum;
    __device__ __forceinline__ void operator()(const f32x4 (&acc)[2][2][4][2], const Unit& u, int wr, int wc, int fr, int fq) const {
        const int row0 = u.pm * BM + wr * 64 + fr;
        if constexpr (MODE == 1) {
            const int col0 = u.pn * HALF + wc * 32 + 8 * fq;
#pragma unroll
            for (int ai = 0; ai < 2; ++ai)
#pragma unroll
                for (int m = 0; m < 4; ++m) {
                    bf16_t* rowp = O + (size_t)(row0 + ai * HALF + m * 16) * ldc + col0;
                    float h[8];
#pragma unroll
                    for (int n = 0; n < 2; ++n)
#pragma unroll
                        for (int e = 0; e < 4; ++e) { const float a = acc[ai][0][m][n][e], b = acc[ai][1][m][n][e]; h[n * 4 + e] = a * sigmoid_f(a) * b; }
                    u32x4 w; w.x = cvt_pk_bf16(h[0], h[1]); w.y = cvt_pk_bf16(h[2], h[3]); w.z = cvt_pk_bf16(h[4], h[5]); w.w = cvt_pk_bf16(h[6], h[7]);
                    *(u32x4*)rowp = w;
                }
        } else {
            const int col0 = u.pn * BM + wc * 32 + 8 * fq;
#pragma unroll
            for (int bj = 0; bj < 2; ++bj) {
                const int c = col0 + bj * HALF;
                f32x4 bv0 = (f32x4){0.f, 0.f, 0.f, 0.f}, bv1 = bv0;
                if constexpr (MODE == 2) { bv0 = *(const f32x4*)(bias + c); bv1 = *(const f32x4*)(bias + c + 4); }
#pragma unroll
                for (int ai = 0; ai < 2; ++ai)
#pragma unroll
                    for (int m = 0; m < 4; ++m) {
                        const size_t row = (size_t)(row0 + ai * HALF + m * 16);
                        f32x4 v0 = acc[ai][bj][m][0], v1 = acc[ai][bj][m][1];
                        if constexpr (MODE == 2) {
                            v0 = v0 + bv0; v1 = v1 + bv1;
#pragma unroll
                            for (int e = 0; e < 4; ++e) { v0[e] = sigmoid_f(v0[e]); v1[e] = sigmoid_f(v1[e]); }
                        }
                        if constexpr (MODE == 3) {
                            const u32x4 g = *(const u32x4*)(G + row * ldg + c);
                            v0[0] *= bf_lo(g.x); v0[1] *= bf_hi(g.x); v0[2] *= bf_lo(g.y); v0[3] *= bf_hi(g.y);
                            v1[0] *= bf_lo(g.z); v1[1] *= bf_hi(g.z); v1[2] *= bf_lo(g.w); v1[3] *= bf_hi(g.w);
                            if (accum) {
                                const u32x4 pv = *(const u32x4*)(O + row * ldc + c);
                                v0[0] += bf_lo(pv.x); v0[1] += bf_hi(pv.x); v0[2] += bf_lo(pv.y); v0[3] += bf_hi(pv.y);
                                v1[0] += bf_lo(pv.z); v1[1] += bf_hi(pv.z); v1[2] += bf_lo(pv.w); v1[3] += bf_hi(pv.w);
                            }
                        }
                        u32x4 w; w.x = cvt_pk_bf16(v0[0], v0[1]); w.y = cvt_pk_bf16(v0[2], v0[3]); w.z = cvt_pk_bf16(v1[0], v1[1]); w.w = cvt_pk_bf16(v1[2], v1[3]);
                        *(u32x4*)(O + row * ldc + c) = w;
                    }
            }
        }
    }
};

template <class Epi, class Sched, bool ALIGN_EPI = true>
__device__ __forceinline__ void gemm_phase(PG8_LAS unsigned char* lds, const Gemm g, const Sched& S, const Epi& E, const int tid) {
    const int wid = __builtin_amdgcn_readfirstlane(tid >> 6), lane = tid & 63, wr = wid >> 2, wc = wid & 3, fr = lane & 15, fq = lane >> 4;
    const int K = g.K, nt = K / BK, lda = g.lda;
    unsigned voffA[2], voffB[2];
#pragma unroll
    for (int i = 0; i < 2; ++i) { int R, C; stage_rc(tid * 16 + i * 8192, R, C); const int Rb = Epi::PERM ? ((R & ~31) + perm32(R & 31)) : R;
        voffA[i] = (unsigned)(R * lda + C) * 2u; voffB[i] = (unsigned)(Rb * K + C) * 2u; }
    const size_t kstep = (size_t)(BK * 2);
    const size_t hstepA = (size_t)HALF * lda * 2, hstepB = (size_t)HALF * K * 2;
    const size_t tstepA = 2 * hstepA, tstepB = 2 * hstepB;
    const unsigned ldsw = (unsigned)wid * 1024u;
    const int aoff = lds_byte(wr * 64 + fr, fq * 8), boff = lds_byte(wc * 32 + fr, fq * 8);
#define PG8_SA(b, h) (((b) * 2 + (h)) * HTB)
#define PG8_SB(b, h) ((4 + (b) * 2 + (h)) * HTB)
#define PG8_STAGE(bufoff, gbase, voff) do { _Pragma("unroll") for (int _i = 0; _i < 2; ++_i) \
        __builtin_amdgcn_global_load_lds((const unsigned*)((const char*)(gbase) + (voff)[_i]), (PG8_LAS unsigned*)(lds + (bufoff) + ldsw + _i * 8192), 16, 0, 0); } while (0)
#define PG8_LDA(dst, b, h) do { _Pragma("unroll") for (int m = 0; m < 4; ++m) _Pragma("unroll") for (int k = 0; k < 2; ++k) dst[m][k] = *(const PG8_LAS bf16x8*)(lds + PG8_SA(b, h) + aoff + m * 2048 + k * 1024); } while (0)
#define PG8_LDB(dst, b, h) do { _Pragma("unroll") for (int n = 0; n < 2; ++n) _Pragma("unroll") for (int k = 0; k < 2; ++k) dst[n][k] = *(const PG8_LAS bf16x8*)(lds + PG8_SB(b, h) + boff + n * 2048 + k * 1024); } while (0)
#define PG8_MMA(ai, bj, At, Bt) do { __builtin_amdgcn_s_setprio(1); _Pragma("unroll") for (int m = 0; m < 4; ++m) _Pragma("unroll") for (int n = 0; n < 2; ++n) _Pragma("unroll") for (int k = 0; k < 2; ++k) \
        acc[ai][bj][m][n] = __builtin_amdgcn_mfma_f32_16x16x32_bf16(Bt[n][k], At[m][k], acc[ai][bj][m][n], 0, 0, 0); __builtin_amdgcn_s_setprio(0); } while (0)
#define PG8_WAIT_V(n) asm volatile("s_waitcnt vmcnt(" #n ")" ::: "memory")
#define PG8_WAIT_L(n) asm volatile("s_waitcnt lgkmcnt(" #n ")" ::: "memory")
#define PG8_BAR __builtin_amdgcn_s_barrier()
#define PG8_SCHED __builtin_amdgcn_sched_barrier(0)
    Unit cur, nxt; int ui = 0;
    if (!S.next(0, cur)) return;
    f32x4 acc[2][2][4][2];
#pragma unroll
    for (int a = 0; a < 2; ++a)
#pragma unroll
        for (int b = 0; b < 2; ++b)
#pragma unroll
            for (int m = 0; m < 4; ++m)
#pragma unroll
                for (int n = 0; n < 2; ++n) acc[a][b][m][n] = (f32x4){0.f, 0.f, 0.f, 0.f};
    bf16x8 At[4][2], B0[2][2], B1[2][2];
    const char* cA = (const char*)g.A + (size_t)cur.pm * tstepA; const char* cB = (const char*)g.Bt + (size_t)cur.pn * tstepB;
    S.a_ready(cur);
    PG8_STAGE(PG8_SB(0, 0), cB, voffB); PG8_STAGE(PG8_SB(0, 1), cB + hstepB, voffB); PG8_STAGE(PG8_SA(0, 0), cA, voffA); PG8_STAGE(PG8_SA(0, 1), cA + hstepA, voffA);
    if (wr == 1) PG8_BAR;
    PG8_WAIT_V(2); PG8_BAR;
    PG8_STAGE(PG8_SB(1, 0), cB + kstep, voffB); PG8_STAGE(PG8_SA(1, 0), cA + kstep, voffA); PG8_STAGE(PG8_SB(1, 1), cB + hstepB + kstep, voffB);
    PG8_WAIT_V(6); PG8_BAR;
    for (;;) {
        const bool has_next = S.next(ui + 1, nxt);
        const char* nA = has_next ? (const char*)g.A + (size_t)nxt.pm * tstepA : cA; const char* nB = has_next ? (const char*)g.Bt + (size_t)nxt.pn * tstepB : cB;
        for (int t = 0; t < nt; t += 2) {
            const bool last = (t == nt - 2);
            const char* a1 = cA + (size_t)(t + 1) * kstep;
            const char* a2 = last ? nA : cA + (size_t)(t + 2) * kstep; const char* b2 = last ? nB : cB + (size_t)(t + 2) * kstep;
            const char* a3 = a2 + kstep; const char* b3 = b2 + kstep;
            if (last && has_next) S.a_ready(nxt);
            PG8_LDB(B0, 0, 0); PG8_LDB(B1, 0, 1); PG8_SCHED; PG8_LDA(At, 0, 0); PG8_STAGE(PG8_SA(1, 1), a1 + hstepA, voffA);
            PG8_WAIT_V(8); PG8_WAIT_L(0); PG8_BAR; PG8_MMA(0, 0, At, B0); PG8_MMA(0, 1, At, B1); PG8_BAR; PG8_SCHED;
            PG8_LDA(At, 0, 1); PG8_STAGE(PG8_SB(0, 0), b2, voffB); PG8_STAGE(PG8_SB(0, 1), b2 + hstepB, voffB); PG8_STAGE(PG8_SA(0, 0), a2, voffA);
            PG8_WAIT_V(8); PG8_WAIT_L(0); PG8_BAR; PG8_MMA(1, 0, At, B0); PG8_MMA(1, 1, At, B1); PG8_BAR; PG8_SCHED;
            PG8_LDB(B0, 1, 0); PG8_LDB(B1, 1, 1); PG8_SCHED; PG8_LDA(At, 1, 0); PG8_STAGE(PG8_SA(0, 1), a2 + hstepA, voffA);
            PG8_WAIT_V(8); PG8_WAIT_L(0); PG8_BAR; PG8_MMA(0, 0, At, B0); PG8_MMA(0, 1, At, B1); PG8_BAR; PG8_SCHED;
            PG8_LDA(At, 1, 1); PG8_STAGE(PG8_SB(1, 0), b3, voffB); PG8_STAGE(PG8_SB(1, 1), b3 + hstepB, voffB); PG8_STAGE(PG8_SA(1, 0), a3, voffA);
            PG8_WAIT_V(8); PG8_WAIT_L(0); PG8_BAR; PG8_MMA(1, 0, At, B0); PG8_MMA(1, 1, At, B1); PG8_BAR; PG8_SCHED;
        }
        if constexpr (ALIGN_EPI) { if (wr == 0) PG8_BAR; }
        E(acc, cur, wr, wc, fr, fq); S.done(cur);
        if (!has_next) break;
#pragma unroll
        for (int a = 0; a < 2; ++a)
#pragma unroll
            for (int b = 0; b < 2; ++b)
#pragma unroll
                for (int m = 0; m < 4; ++m)
#pragma unroll
                    for (int n = 0; n < 2; ++n) acc[a][b][m][n] = (f32x4){0.f, 0.f, 0.f, 0.f};
        cur = nxt; cA = nA; cB = nB; ++ui;
        if constexpr (ALIGN_EPI) { if (wr == 1) PG8_BAR; }
    }
    PG8_WAIT_V(0);
    if constexpr (!ALIGN_EPI) { if (wr == 0) PG8_BAR; }
    PG8_BAR;
#undef PG8_SA
#undef PG8_SB
#undef PG8_STAGE
#undef PG8_LDA
#undef PG8_LDB
#undef PG8_MMA
#undef PG8_WAIT_V
#undef PG8_WAIT_L
#undef PG8_BAR
#undef PG8_SCHED
}
}

typedef unsigned short bf16;
typedef short bf16x8 __attribute__((ext_vector_type(8)));
typedef float f32x4 __attribute__((ext_vector_type(4)));
typedef float f32x16 __attribute__((ext_vector_type(16)));
typedef unsigned v4u __attribute__((ext_vector_type(4)));
typedef unsigned v2u __attribute__((ext_vector_type(2)));

constexpr int DM = 1024, NBATCH = 4, SEQ = 8192, MTOK = NBATCH * SEQ, FFN = 2816, PIN = 2048, NGATE = 3072, MEMLEN = 256, MEMROWS = NBATCH * MEMLEN;
constexpr int NWAVES = 8;
constexpr float EPSN = 1e-6f;
constexpr float LOG2E = 1.4426950408889634f, LN2 = 0.6931471805599453f;
constexpr float C2 = 0.125f * LOG2E;

constexpr size_t MiB = (size_t)1 << 20;
constexpr size_t WS_WB = 1 * MiB, WS_KVMEM = 49 * MiB, WS_MH = 50 * MiB, WS_LSE = 52 * MiB, WS_XN = 54 * MiB, WS_R = 118 * MiB;
constexpr size_t WS_H = WS_R, WS_YF = WS_R + 176 * MiB;
constexpr size_t WS_Z = WS_R, WS_GATES = WS_R + 128 * MiB, WS_OALL = WS_R + 320 * MiB, WS_MERGED = WS_R, WS_YM = WS_R + 64 * MiB;
constexpr size_t WS_END = WS_R + 384 * MiB;
constexpr size_t WO_F1IN = 0, WO_F1OUT = 5767168, WO_WIN = 8650752, WO_WGATE = 10747904, WO_BRA = 13893632, WO_BRB = 14286848, WO_BRC = 14680064,
                 WO_WO = 14942208, WO_F2IN = 15990784, WO_F2OUT = 21757952, WO_MEMKV = 24641536;
constexpr int RING_BYTES = 131072, LUT_OFF = RING_BYTES, LUT_PITCH = 132, MISC_OFF = 139264, LDS_BYTES = 147456;
constexpr size_t WS_CTL = 0, CTL_ZERO_BYTES = 65536;

struct Params { const float* in[18]; float* out; unsigned char* ws; int ph_lo, ph_hi, coop, pad; };

#define LDS_WAIT() asm volatile("s_waitcnt lgkmcnt(0)" ::: "memory")
__device__ __forceinline__ unsigned pk2(float lo, float hi) { return pg8::cvt_pk_bf16(lo, hi); }
__device__ __forceinline__ float wave_sum(float v) {
#pragma unroll
    for (int o = 1; o < 64; o <<= 1) v += __shfl_xor(v, o);
    return v;
}

__device__ __forceinline__ void transpose_item(const float* W, int K, int N, bf16* WT, int k0, int n0, int rowbase, LAS float* scr, int lane) {
    float wv[32];
#pragma unroll
    for (int i = 0; i < 32; ++i) { const int kk = 2 * i + (lane >> 5); wv[i] = W[(size_t)(k0 + kk) * N + n0 + (lane & 31)]; }
#pragma unroll
    for (int i = 0; i < 32; ++i) { const int kk = 2 * i + (lane >> 5); scr[kk * 33 + (lane & 31)] = wv[i]; }
    LDS_WAIT(); asm volatile("" ::: "memory");
    const int c = lane & 7;
#pragma unroll
    for (int j = 0; j < 4; ++j) { const int n = (lane >> 3) + 8 * j; const LAS float* s = scr + (8 * c) * 33 + n;
        v4u o; o.x = pk2(s[0 * 33], s[1 * 33]); o.y = pk2(s[2 * 33], s[3 * 33]); o.z = pk2(s[4 * 33], s[5 * 33]); o.w = pk2(s[6 * 33], s[7 * 33]);
        *(v4u*)(WT + (size_t)(rowbase + n) * K + k0 + 8 * c) = o; }
    LDS_WAIT(); asm volatile("" ::: "memory");
}
__device__ __forceinline__ void tr_plain(const float* W, int K, int N, bf16* WT, int r, LAS float* scr, int lane) {
    const int nblk = N / 32, kb = r / nblk, nb = r % nblk;
    transpose_item(W, K, N, WT, 64 * kb, 32 * nb, 32 * nb, scr, lane);
}
__device__ __forceinline__ void tr_ffnin(const float* W, bf16* WT, int r, LAS float* scr, int lane) {
    const int nblk = (2 * FFN) / 32, kb = r / nblk, nb = r % nblk, n0 = 32 * nb;
    const int isb = n0 >= FFN ? 1 : 0, j = n0 - isb * FFN;
    const int rowbase = (j >> 7) * 256 + isb * 128 + (j & 127);
    transpose_item(W, DM, 2 * FFN, WT, 64 * kb, n0, rowbase, scr, lane);
}

__device__ __forceinline__ void convert_weights(const Params& p, int l, bf16* WB, LAS unsigned char* lds, int gw, int ngw, int wave, int lane) {
    LAS float* scr = (LAS float*)(lds + wave * 16384);
    constexpr int I_FIN = 16 * 176, I_FOUT = 44 * 32, I_WIN = 16 * 64, I_WG = 16 * 96, I_BRA = 6 * 32, I_BRC = 4 * 32, I_WO = 16 * 32, I_MKV = 16 * 16;
    constexpr int NITEMS = 2 * I_FIN + 2 * I_FOUT + I_WIN + I_WG + 2 * I_BRA + I_BRC + I_WO + I_MKV;
    const float* f1in = p.in[5] + (size_t)l * DM * 2 * FFN; const float* f1out = p.in[6] + (size_t)l * FFN * DM;
    const float* win = p.in[7] + (size_t)l * DM * PIN; const float* wmkv = p.in[9] + (size_t)l * DM * 512;
    const float* wgate = p.in[10] + (size_t)l * DM * NGATE;
    const float* bra = p.in[12] + (size_t)l * 384 * DM; const float* brb = p.in[13] + (size_t)l * 384 * DM; const float* brc = p.in[14] + (size_t)l * 256 * DM;
    const float* wo = p.in[15] + (size_t)l * DM * DM; const float* f2in = p.in[16] + (size_t)l * DM * 2 * FFN; const float* f2out = p.in[17] + (size_t)l * FFN * DM;
    for (int it = gw; it < NITEMS; it += ngw) {
        int r = it;
        if (r < I_FIN) { tr_ffnin(f1in, WB + WO_F1IN, r, scr, lane); continue; } r -= I_FIN;
        if (r < I_FIN) { tr_ffnin(f2in, WB + WO_F2IN, r, scr, lane); continue; } r -= I_FIN;
        if (r < I_FOUT) { tr_plain(f1out, FFN, DM, WB + WO_F1OUT, r, scr, lane); continue; } r -= I_FOUT;
        if (r < I_FOUT) { tr_plain(f2out, FFN, DM, WB + WO_F2OUT, r, scr, lane); continue; } r -= I_FOUT;
        if (r < I_WIN) { tr_plain(win, DM, PIN, WB + WO_WIN, r, scr, lane); continue; } r -= I_WIN;
        if (r < I_WG) { tr_plain(wgate, DM, NGATE, WB + WO_WGATE, r, scr, lane); continue; } r -= I_WG;
        if (r < I_BRA) { tr_plain(bra, 384, DM, WB + WO_BRA, r, scr, lane); continue; } r -= I_BRA;
        if (r < I_BRA) { tr_plain(brb, 384, DM, WB + WO_BRB, r, scr, lane); continue; } r -= I_BRA;
        if (r < I_BRC) { tr_plain(brc, 256, DM, WB + WO_BRC, r, scr, lane); continue; } r -= I_BRC;
        if (r < I_WO) { tr_plain(wo, DM, DM, WB + WO_WO, r, scr, lane); continue; } r -= I_WO;
        tr_plain(wmkv, DM, 512, WB + WO_MEMKV, r, scr, lane);
    }
}

__device__ __forceinline__ void row_pass(const float* xin, const bf16* y, const float* gpost, float scale, float* xout, const float* gpre, bf16* xn, int lane) {
    const f32x4* xr = (const f32x4*)xin + lane;
    f32x4 v[4];
#pragma unroll
    for (int j = 0; j < 4; ++j) v[j] = xr[64 * j];
    if (y) {
        const v2u* yr = (const v2u*)y + lane;
        f32x4 yv[4]; float ss = 0.f;
#pragma unroll
        for (int j = 0; j < 4; ++j) { const v2u w = yr[64 * j]; yv[j] = (f32x4){pg8::bf_lo(w.x), pg8::bf_hi(w.x), pg8::bf_lo(w.y), pg8::bf_hi(w.y)};
            ss += (yv[j].x * yv[j].x + yv[j].y * yv[j].y) + (yv[j].z * yv[j].z + yv[j].w * yv[j].w); }
        const float rs = scale / sqrtf(wave_sum(ss) * (1.f / DM) + EPSN);
#pragma unroll
        for (int j = 0; j < 4; ++j) { const f32x4 g = ((const f32x4*)gpost)[lane + 64 * j]; v[j] = v[j] + yv[j] * g * rs; }
    }
    if (xout) {
        f32x4* xo = (f32x4*)xout + lane;
#pragma unroll
        for (int j = 0; j < 4; ++j) xo[64 * j] = v[j];
    }
    if (xn) {
        float s2 = 0.f;
#pragma unroll
        for (int j = 0; j < 4; ++j) s2 += (v[j].x * v[j].x + v[j].y * v[j].y) + (v[j].z * v[j].z + v[j].w * v[j].w);
        const float rstd = 1.f / sqrtf(wave_sum(s2) * (1.f / DM) + EPSN);
        v2u* o8 = (v2u*)xn + lane;
#pragma unroll
        for (int j = 0; j < 4; ++j) { const f32x4 g = ((const f32x4*)gpre)[lane + 64 * j]; const f32x4 t = v[j] * g * rstd;
            v2u w; w.x = pk2(t.x, t.y); w.y = pk2(t.z, t.w); o8[64 * j] = w; }
    }
}

template <int R>
__device__ __forceinline__ void row_pass_n(const float* xin, const bf16* y, const float* gpost, float scale, float* xout, const float* gpre, bf16* xn, size_t rstride, int lane) {
    f32x4 v[R][4]; v2u yw[R][4];
#pragma unroll
    for (int r = 0; r < R; ++r)
#pragma unroll
        for (int j = 0; j < 4; ++j) v[r][j] = ((const f32x4*)(xin + r * rstride))[lane + 64 * j];
    if (y) {
#pragma unroll
        for (int r = 0; r < R; ++r)
#pragma unroll
            for (int j = 0; j < 4; ++j) yw[r][j] = ((const v2u*)(y + r * rstride))[lane + 64 * j];
        f32x4 gp[4];
#pragma unroll
        for (int j = 0; j < 4; ++j) gp[j] = ((const f32x4*)gpost)[lane + 64 * j];
#pragma unroll
        for (int r = 0; r < R; ++r) {
            f32x4 yv[4]; float ss = 0.f;
#pragma unroll
            for (int j = 0; j < 4; ++j) { const v2u w = yw[r][j]; yv[j] = (f32x4){pg8::bf_lo(w.x), pg8::bf_hi(w.x), pg8::bf_lo(w.y), pg8::bf_hi(w.y)};
                ss += (yv[j].x * yv[j].x + yv[j].y * yv[j].y) + (yv[j].z * yv[j].z + yv[j].w * yv[j].w); }
            const float rs = scale / sqrtf(wave_sum(ss) * (1.f / DM) + EPSN);
#pragma unroll
            for (int j = 0; j < 4; ++j) v[r][j] = v[r][j] + yv[j] * gp[j] * rs;
        }
    }
    if (xout) {
#pragma unroll
        for (int r = 0; r < R; ++r)
#pragma unroll
            for (int j = 0; j < 4; ++j) ((f32x4*)(xout + r * rstride))[lane + 64 * j] = v[r][j];
    }
    if (xn) {
        f32x4 gq[4];
#pragma unroll
        for (int j = 0; j < 4; ++j) gq[j] = ((const f32x4*)gpre)[lane + 64 * j];
#pragma unroll
        for (int r = 0; r < R; ++r) {
            float s2 = 0.f;
#pragma unroll
            for (int j = 0; j < 4; ++j) s2 += (v[r][j].x * v[r][j].x + v[r][j].y * v[r][j].y) + (v[r][j].z * v[r][j].z + v[r][j].w * v[r][j].w);
            const float rstd = 1.f / sqrtf(wave_sum(s2) * (1.f / DM) + EPSN);
#pragma unroll
            for (int j = 0; j < 4; ++j) { const f32x4 t = v[r][j] * gq[j] * rstd; v2u w; w.x = pk2(t.x, t.y); w.y = pk2(t.z, t.w); ((v2u*)(xn + r * rstride))[lane + 64 * j] = w; }
        }
    }
}

__device__ __forceinline__ int crow(int r, int hi) { return (r & 3) + 8 * (r >> 2) + 4 * hi; }
#define MFMA32(a, b, c) __builtin_amdgcn_mfma_f32_32x32x16_bf16((a), (b), (c), 0, 0, 0)

template <bool MASKED>
__device__ __forceinline__ void attn_wave(const bf16* qp, long qstep, const bf16* kp, long kstep, const bf16* vp, long vstep, bf16* op, long ostep,
                                          float* lsep, long lsestep, int i0, int t_lo, int t_hi, int maxd, const LAS float* lut, float m0, float l0, int lane) {
    const int q = lane & 31, hi = lane >> 5, qi = i0 + q;
    bf16x8 qf[4];
    { const bf16* qrow = qp + (long)qi * qstep + 8 * hi;
#pragma unroll
      for (int d0 = 0; d0 < 4; ++d0) qf[d0] = *(const bf16x8*)(qrow + 16 * d0); }
    float m = m0, l = (hi == 0) ? l0 : 0.f;
    f32x16 o0, o1;
#pragma unroll
    for (int r = 0; r < 16; ++r) { o0[r] = 0.f; o1[r] = 0.f; }
    const unsigned koff = (unsigned)(q * (int)kstep + 8 * hi), voff = (unsigned)(4 * hi * (int)vstep + q);
#define ATT_LOADT(tt, KF, VA) do { const int kv0_ = 32 * (tt); const bf16* kt_ = kp + (long)kv0_ * kstep; \
        _Pragma("unroll") for (int d0 = 0; d0 < 4; ++d0) KF[d0] = *(const bf16x8*)(kt_ + 16 * d0 + koff); \
        _Pragma("unroll") for (int s = 0; s < 2; ++s) _Pragma("unroll") for (int db = 0; db < 2; ++db) _Pragma("unroll") for (int j = 0; j < 8; ++j) { \
            const bf16* vt_ = vp + (long)(kv0_ + 16 * s + 8 * (j >> 2) + (j & 3)) * vstep + 32 * db; VA[s * 2 + db][j] = (short)vt_[voff]; } } while (0)
    bf16x8 kf[4], va[4];
    ATT_LOADT(t_lo, kf, va);
    for (int t = t_lo; t <= t_hi; ++t) {
        const int kv0 = 32 * t;
        bf16x8 kn[4], vn[4];
#pragma unroll
        for (int i = 0; i < 4; ++i) { kn[i] = kf[i]; vn[i] = va[i]; }
        if (t < t_hi) ATT_LOADT(t + 1, kn, vn);
        f32x16 p;
#pragma unroll
        for (int r = 0; r < 16; ++r) p[r] = 0.f;
#pragma unroll
        for (int d0 = 0; d0 < 4; ++d0) p = MFMA32(kf[d0], qf[d0], p);
        float tmax = -INFINITY;
#pragma unroll
        for (int r = 0; r < 16; ++r) {
            float s = p[r] * C2;
            if (MASKED) {
                const int dist = qi - (kv0 + crow(r, hi));
                const bool ok = (dist >= 0) && (dist <= maxd);
                const int di = dist < 0 ? 0 : (dist > 128 ? 128 : dist);
                s += lut[di];
                s = ok ? s : -INFINITY;
            }
            p[r] = s; tmax = fmaxf(tmax, s);
        }
        tmax = fmaxf(tmax, __shfl_xor(tmax, 32));
        const float mn = fmaxf(m, tmax);
        const float sc = __builtin_amdgcn_exp2f(m - mn);
        m = mn; l *= sc;
#pragma unroll
        for (int r = 0; r < 16; ++r) { o0[r] *= sc; o1[r] *= sc; }
        float ps = 0.f;
#pragma unroll
        for (int r = 0; r < 16; ++r) { const float e = __builtin_amdgcn_exp2f(p[r] - mn); p[r] = e; ps += e; }
        l += ps;
        v4u pw0, pw1;
        pw0.x = pk2(p[0], p[1]); pw0.y = pk2(p[2], p[3]); pw0.z = pk2(p[4], p[5]); pw0.w = pk2(p[6], p[7]);
        pw1.x = pk2(p[8], p[9]); pw1.y = pk2(p[10], p[11]); pw1.z = pk2(p[12], p[13]); pw1.w = pk2(p[14], p[15]);
        const bf16x8 pb0 = __builtin_bit_cast(bf16x8, pw0), pb1 = __builtin_bit_cast(bf16x8, pw1);
        o0 = MFMA32(va[0], pb0, o0); o1 = MFMA32(va[1], pb0, o1);
        o0 = MFMA32(va[2], pb1, o0); o1 = MFMA32(va[3], pb1, o1);
#pragma unroll
        for (int i = 0; i < 4; ++i) { kf[i] = kn[i]; va[i] = vn[i]; }
    }
#undef ATT_LOADT
    l += __shfl_xor(l, 32);
    const float inv = 1.f / l;
    bf16* orow = op + (long)qi * ostep + 4 * hi;
#pragma unroll
    for (int g = 0; g < 4; ++g) {
        v2u w0, w1;
        w0.x = pk2(o0[4 * g] * inv, o0[4 * g + 1] * inv); w0.y = pk2(o0[4 * g + 2] * inv, o0[4 * g + 3] * inv);
        w1.x = pk2(o1[4 * g] * inv, o1[4 * g + 1] * inv); w1.y = pk2(o1[4 * g + 2] * inv, o1[4 * g + 3] * inv);
        *(v2u*)(orow + 8 * g) = w0; *(v2u*)(orow + 32 + 8 * g) = w1;
    }
    if (lsep && hi == 0) lsep[(long)qi * lsestep] = m * LN2 + logf(l);
}

#define XB_TMO      128
#define XB_XCNT(j)  (256  + 64 * (j))
#define XB_XSUB(j)  (1280 + 64 * (j))
#define XB_XGEN(j)  (2304 + 64 * (j))
#define XB_TOP      3328
#define XB_TOPGEN   3392
#define XCD_BAR_WORDS 3456
#define XB_SPIN_CAP (1u << 18)

__device__ __forceinline__ unsigned xb_ld(unsigned* p)              { return __hip_atomic_load(p, __ATOMIC_RELAXED, __HIP_MEMORY_SCOPE_AGENT); }
__device__ __forceinline__ unsigned xb_add(unsigned* p, unsigned v) { return __hip_atomic_fetch_add(p, v, __ATOMIC_RELAXED, __HIP_MEMORY_SCOPE_AGENT); }
__device__ __forceinline__ unsigned xb_xcc_id() { return (unsigned)__builtin_amdgcn_s_getreg((3 << 11) | 20) & 0xFu; }
#define XB_SPIN(cond, bar) do { unsigned _sp = 0; while (cond) { __builtin_amdgcn_s_sleep(1); \
    if ((++_sp & 255u) == 0u) { if (xb_ld(&(bar)[XB_TMO])) break; if (_sp > XB_SPIN_CAP) { atomicAdd(&(bar)[XB_TMO], 1u); break; } } } } while (0)

struct XcdBarrier {
    unsigned* bar; unsigned x;
    volatile LAS unsigned* st;
};

__device__ __forceinline__ XcdBarrier xcd_barrier_post(unsigned* bar, volatile LAS unsigned* st) {
    XcdBarrier b; b.bar = bar; b.x = xb_xcc_id(); b.st = st;
    if (threadIdx.x == 0) (void)xb_add(&bar[XB_XCNT(b.x)], 1u);
    return b;
}
__device__ __forceinline__ void xcd_barrier_complete(unsigned* bar, unsigned x, unsigned& nloc, unsigned& nx) {
    const unsigned G = gridDim.x * gridDim.y * gridDim.z;
    unsigned sum, cnt, mine, sp = 0u;
    for (;;) {
        sum = 0u; cnt = 0u; mine = 0u;
#pragma unroll
        for (unsigned j = 0; j < 16; ++j) { const unsigned c = xb_ld(&bar[XB_XCNT(j)]); sum += c; cnt += (c > 0u) ? 1u : 0u; mine = (j == x) ? c : mine; }
        if (sum == G) break;
        __builtin_amdgcn_s_sleep(1);
        if ((++sp & 255u) == 0u) { if (xb_ld(&bar[XB_TMO])) break; if (sp > XB_SPIN_CAP) { atomicAdd(&bar[XB_TMO], 1u); break; } }
    }
    nloc = mine > 0u ? mine : 1u; nx = cnt > 0u ? cnt : 1u;
}

__device__ __forceinline__ void xcd_barrier(const XcdBarrier& b) {
    asm volatile("s_waitcnt vmcnt(0)" ::: "memory");
    __syncthreads();
    if (threadIdx.x == 0) {
        unsigned* bar = b.bar;
        __builtin_amdgcn_s_waitcnt(0);
        unsigned nloc = b.st[0], nx = b.st[1];
        if (nloc == 0u) { xcd_barrier_complete(bar, b.x, nloc, nx); b.st[0] = nloc; b.st[1] = nx; }
        const unsigned old = xb_add(&bar[XB_XSUB(b.x)], 1u);
        const unsigned gen = old / nloc;
        if (old + 1u == (gen + 1u) * nloc) {
            __builtin_amdgcn_fence(__ATOMIC_RELEASE, "agent");
            asm volatile("s_waitcnt vmcnt(0)" ::: "memory");
            const unsigned og = xb_add(&bar[XB_TOP], 1u);
            const unsigned tg = og / nx;
            if (og + 1u == (tg + 1u) * nx) xb_add(&bar[XB_TOPGEN], 1u);
            else XB_SPIN(xb_ld(&bar[XB_TOPGEN]) == tg, bar);
            __builtin_amdgcn_fence(__ATOMIC_ACQUIRE, "agent");
            xb_add(&bar[XB_XGEN(b.x)], 1u);
            asm volatile("s_waitcnt vmcnt(0)" ::: "memory");
        } else {
            XB_SPIN(xb_ld(&bar[XB_XGEN(b.x)]) == gen, bar);
            __builtin_amdgcn_fence(__ATOMIC_ACQUIRE, "agent");
            asm volatile("s_waitcnt vmcnt(0)" ::: "memory");
        }
    }
    __syncthreads();
}

struct Job { int mode; const bf16* A; int lda; const bf16* Bt; int M, N, K; bf16* O; int ldc; const float* bias; const bf16* G; int ldg; int accum; };

__device__ __forceinline__ void run_job(const Job& J, LAS unsigned char* lds, int G, int bid, int tid) {
    pg8::Gemm g{J.A, J.Bt, J.M, J.N, J.K, J.lda};
    pg8::StaticOrder S; S.init(J.M, J.N, G, bid);
    if (J.mode == 0) { pg8::Epi<0> E{J.O, J.ldc, J.bias, J.G, J.ldg, J.accum}; pg8::gemm_phase<pg8::Epi<0>, pg8::StaticOrder, true>(lds, g, S, E, tid); }
    else if (J.mode == 1) { pg8::Epi<1> E{J.O, J.ldc, J.bias, J.G, J.ldg, J.accum}; pg8::gemm_phase<pg8::Epi<1>, pg8::StaticOrder, true>(lds, g, S, E, tid); }
    else if (J.mode == 2) { pg8::Epi<2> E{J.O, J.ldc, J.bias, J.G, J.ldg, J.accum}; pg8::gemm_phase<pg8::Epi<2>, pg8::StaticOrder, true>(lds, g, S, E, tid); }
    else { pg8::Epi<3> E{J.O, J.ldc, J.bias, J.G, J.ldg, J.accum}; pg8::gemm_phase<pg8::Epi<3>, pg8::StaticOrder, true>(lds, g, S, E, tid); }
}

__global__ void __launch_bounds__(NWAVES * 64, 2) mega_fwd(Params p) {
    extern __shared__ __attribute__((aligned(16))) unsigned char lds_raw[];
    LAS unsigned char* lds = (LAS unsigned char*)lds_raw;
    const int G = gridDim.x, bid = blockIdx.x;
    LAS float* lut = (LAS float*)(lds + LUT_OFF);
    const float* rel_bias = p.in[2];
    const int tid = threadIdx.x;

    for (int i = tid; i < 12 * 129; i += NWAVES * 64) {
        const int h = i / 129, dist = i % 129;
        const int rate = h < 8 ? 1 : (h < 10 ? 4 : 16);
        const int d = dist * rate;
        int bucket;
        if (d < 16) bucket = d;
        else { const float fd = (float)d; int large = 16 + (int)(logf(fd / 16.0f) / 4.852030263919617f * 16.0f); bucket = large < 31 ? large : 31; }
        lut[h * LUT_PITCH + dist] = rel_bias[bucket * 12 + h] * LOG2E;
    }
    if (tid < 32) ((LAS unsigned*)(lds + MISC_OFF))[tid] = 0u;
    __syncthreads();

    cg::grid_group grid = cg::this_grid();
    XcdBarrier bar; bar.bar = (unsigned*)(p.ws + WS_CTL); bar.x = 0; bar.st = nullptr;
    if (p.coop) bar = xcd_barrier_post((unsigned*)(p.ws + WS_CTL), (volatile LAS unsigned*)(lds + MISC_OFF) + 8);
    for (int ph = p.ph_lo; ph < p.ph_hi; ++ph) {
        int tidv = threadIdx.x; asm volatile("" : "+v"(tidv));
        const int lane = tidv & 63, wave = __builtin_amdgcn_readfirstlane(tidv >> 6);
        const int gw = bid * NWAVES + wave, ngw = G * NWAVES;
        unsigned char* ws = p.ws; asm volatile("" : "+s"(ws));
        float* out = p.out; asm volatile("" : "+s"(out));
        bf16* WB = (bf16*)(ws + WS_WB); bf16* KVMEM = (bf16*)(ws + WS_KVMEM); bf16* MH = (bf16*)(ws + WS_MH); float* LSE = (float*)(ws + WS_LSE);
        bf16* XN = (bf16*)(ws + WS_XN); bf16* H = (bf16*)(ws + WS_H); bf16* YF = (bf16*)(ws + WS_YF); bf16* Z = (bf16*)(ws + WS_Z);
        bf16* OBT = (bf16*)(ws + WS_XN);
        bf16* GATES = (bf16*)(ws + WS_GATES); bf16* OALL = (bf16*)(ws + WS_OALL); bf16* MERGED = (bf16*)(ws + WS_MERGED); bf16* YM = (bf16*)(ws + WS_YM);
        const float* x_in = p.in[0]; const float* mem = p.in[1]; const float* norm_gain = p.in[3]; const float* mem_gain = p.in[4];
        const float* sinks = p.in[8]; const float* b_gate = p.in[11];
        if (ph == 0) {
            convert_weights(p, 0, WB, lds, gw, ngw, wave, lane);
            for (int m = gw; m < MEMROWS; m += ngw) row_pass(mem + (size_t)m * DM, nullptr, nullptr, 0.f, nullptr, mem_gain, MH + (size_t)m * DM, lane);
            for (int m = gw; m < MTOK; m += 4 * ngw) row_pass_n<4>(x_in + (size_t)m * DM, nullptr, nullptr, 0.f, nullptr, norm_gain, XN + (size_t)m * DM, (size_t)ngw * DM, lane);
        } else {
            const int l = (ph - 1) / 12, lp = (ph - 1) % 12;
            const float* gn = norm_gain + (size_t)l * 6 * DM;
            if (lp == 0 || lp == 1 || lp == 2 || lp == 3 || lp == 6 || lp == 7 || lp == 9 || lp == 10) {
                const int njobs = (lp == 3) ? 2 : (lp == 6 ? 3 : 1);
                for (int rep = 0; rep < REP_GEMM; ++rep)
                for (int j = 0; j < njobs; ++j) {
                    Job J; J.bias = nullptr; J.G = nullptr; J.ldg = 0; J.accum = 0; J.M = MTOK;
                    if (lp == 0 || lp == 9) { J.mode = 1; J.A = XN; J.lda = DM; J.K = DM; J.Bt = WB + (lp == 0 ? WO_F1IN : WO_F2IN); J.N = 2 * FFN; J.O = H; J.ldc = FFN; }
                    else if (lp == 1 || lp == 10) { J.mode = 0; J.A = H; J.lda = FFN; J.K = FFN; J.Bt = WB + (lp == 1 ? WO_F1OUT : WO_F2OUT); J.N = DM; J.O = YF; J.ldc = DM; }
                    else if (lp == 2) { J.mode = 0; J.A = MH; J.lda = DM; J.K = DM; J.Bt = WB + WO_MEMKV; J.M = MEMROWS; J.N = 512; J.O = KVMEM; J.ldc = 512; }
                    else if (lp == 3) {
                        if (j == 0) { J.mode = 0; J.A = XN; J.lda = DM; J.K = DM; J.Bt = WB + WO_WIN; J.N = PIN; J.O = Z; J.ldc = PIN; }
                        else { J.mode = 2; J.A = XN; J.lda = DM; J.K = DM; J.Bt = WB + WO_WGATE; J.N = NGATE; J.O = GATES; J.ldc = NGATE; J.bias = b_gate + (size_t)l * NGATE; }
                    }
                    else if (lp == 6) {
                        J.mode = 3; J.lda = DM; J.N = DM; J.O = MERGED; J.ldc = DM; J.ldg = NGATE; J.accum = j > 0 ? 1 : 0;
                        if (j == 0) { J.A = OALL; J.K = 384; J.Bt = WB + WO_BRA; J.G = GATES; }
                        else if (j == 1) { J.A = OALL + 384; J.K = 384; J.Bt = WB + WO_BRB; J.G = GATES + DM; }
                        else { J.A = OALL + 768; J.K = 256; J.Bt = WB + WO_BRC; J.G = GATES + 2 * DM; }
                    }
                    else { J.mode = 0; J.A = MERGED; J.lda = DM; J.K = DM; J.Bt = WB + WO_WO; J.N = DM; J.O = YM; J.ldc = DM; }
                    run_job(J, lds, G, bid, tidv);
                }
            }
            if (lp == 2) {
                const float* xin = (l == 0) ? x_in : out;
                for (int rep = 0; rep < REP_ROW; ++rep)
                for (int m = gw; m < MTOK; m += 4 * ngw) row_pass_n<4>(xin + (size_t)m * DM, YF + (size_t)m * DM, gn + 1 * DM, rep == REP_ROW - 1 ? 0.5f : 0.f, out + (size_t)m * DM, gn + 2 * DM, XN + (size_t)m * DM, (size_t)ngw * DM, lane);
            } else if (lp == 4) {
                for (int rep = 0; rep < REP_ATTN; ++rep)
                for (int tk = gw; tk < 6144; tk += ngw) {
                    const int sl = tk & 255, b = (tk >> 8) & 3, hd = tk >> 10;
                    const int gi = hd >> 1, sh = 2 * gi;
                    const int spr = 256 >> sh;
                    const int rho = sl / spr, i0 = 32 * (sl % spr);
                    const long row0 = (long)b * SEQ + rho, st = 1L << sh;
                    const int t_hi = i0 >> 5, t_lo = t_hi >= 4 ? t_hi - 4 : 0;
                    attn_wave<true>(Z + row0 * PIN + 640 + hd * 64, st * PIN, Z + row0 * PIN + 1024 + hd * 64, st * PIN, Z + row0 * PIN + 1408 + hd * 64, st * PIN,
                                    OBT + row0 * 384 + hd * 64, st * 384, LSE + row0 * 6 + hd, st * 6, i0, t_lo, t_hi, 128, lut + (6 + hd) * LUT_PITCH, -1e30f, 0.f, lane);
                }
            } else if (lp == 5) {
                for (int rep = 0; rep < REP_ATTN; ++rep) {
                for (int tk = gw; tk < 6144; tk += ngw) {
                    const int sl = tk & 255, bh = tk >> 8, b = bh / 6, h = bh % 6, kvh = h / 3;
                    const int i0 = 32 * sl; const long row0 = (long)b * SEQ;
                    const int t_hi = sl, t_lo = t_hi >= 4 ? t_hi - 4 : 0;
                    attn_wave<true>(Z + row0 * PIN + h * 64, PIN, Z + row0 * PIN + 384 + kvh * 64, PIN, Z + row0 * PIN + 512 + kvh * 64, PIN,
                                    OALL + row0 * DM + h * 64, DM, nullptr, 0, i0, t_lo, t_hi, 127, lut + h * LUT_PITCH, sinks[l * 6 + h] * LOG2E, 1.f, lane);
                }
                for (int tk = gw; tk < 4096; tk += ngw) {
                    const int sl = tk & 255, bh = tk >> 8, b = bh >> 2, h = bh & 3;
                    const long row0 = (long)b * SEQ;
                    attn_wave<false>(Z + row0 * PIN + 1792 + h * 64, PIN, KVMEM + (long)b * MEMLEN * 512 + h * 64, 512, KVMEM + (long)b * MEMLEN * 512 + 256 + h * 64, 512,
                                     OALL + row0 * DM + 768 + h * 64, DM, nullptr, 0, 32 * sl, 0, 7, 0, lut, -1e30f, 0.f, lane);
                }
                for (int idx = bid * (NWAVES * 64) + tidv; idx < MTOK * 48; idx += G * NWAVES * 64) {
                    const int t = idx / 48, c = idx % 48, head = c >> 3, hg = head & 1;
                    const float* ls = LSE + (size_t)t * 6;
                    const float a0 = ls[hg], a1 = ls[2 + hg], a2 = ls[4 + hg], mine = ls[head];
                    const float mx = fmaxf(a0, fmaxf(a1, a2));
                    const float den = __expf(a0 - mx) + __expf(a1 - mx) + __expf(a2 - mx);
                    const float alpha = __expf(mine - mx) / den;
                    v4u* pp = (v4u*)(OALL + (size_t)t * DM + 384 + c * 8);
                    const v4u w = *(const v4u*)(OBT + (size_t)t * 384 + c * 8); v4u o;
                    o.x = pk2(pg8::bf_lo(w.x) * alpha, pg8::bf_hi(w.x) * alpha); o.y = pk2(pg8::bf_lo(w.y) * alpha, pg8::bf_hi(w.y) * alpha);
                    o.z = pk2(pg8::bf_lo(w.z) * alpha, pg8::bf_hi(w.z) * alpha); o.w = pk2(pg8::bf_lo(w.w) * alpha, pg8::bf_hi(w.w) * alpha);
                    *pp = o;
                }
                }
            } else if (lp == 8) {
                for (int rep = 0; rep < REP_ROW; ++rep)
                for (int m = gw; m < MTOK; m += 4 * ngw) row_pass_n<4>(out + (size_t)m * DM, YM + (size_t)m * DM, gn + 3 * DM, rep == REP_ROW - 1 ? 1.0f : 0.f, out + (size_t)m * DM, gn + 4 * DM, XN + (size_t)m * DM, (size_t)ngw * DM, lane);
            } else if (lp == 11) {
                const bool more = (l == 0);
                for (int rep = 0; rep < REP_ROW; ++rep)
                for (int m = gw; m < MTOK; m += 4 * ngw) row_pass_n<4>(out + (size_t)m * DM, YF + (size_t)m * DM, gn + 5 * DM, rep == REP_ROW - 1 ? 0.5f : 0.f, out + (size_t)m * DM,
                                                                more ? norm_gain + 6 * DM : nullptr, more ? XN + (size_t)m * DM : nullptr, (size_t)ngw * DM, lane);
                if (more) {
                    convert_weights(p, 1, WB, lds, gw, ngw, wave, lane);
                    for (int m = gw; m < MEMROWS; m += ngw) row_pass(mem + (size_t)m * DM, nullptr, nullptr, 0.f, nullptr, mem_gain + DM, MH + (size_t)m * DM, lane);
                }
            }
        }
        if (p.coop && ph + 1 < p.ph_hi) {
            if (ph == p.ph_lo) grid.sync();
            else xcd_barrier(bar);
        } else __syncthreads();
    }
}

constexpr int N_PHASES = 25;
extern "C" void kernel_launch(void* const* d_in, const int* in_sizes, int n_in, void* d_out, int out_size, void* d_ws, size_t ws_size, hipStream_t stream) {
    static int grid = 0;
    if (grid == 0) {
        if (n_in != 18 || in_sizes[0] != MTOK * DM || out_size != MTOK * DM || ws_size < WS_END) {
            fprintf(stderr, "kernel_launch: unexpected shapes (n_in %d, in0 %d, out %d, ws %zu < %zu); nothing launched\n", n_in, n_in > 0 ? in_sizes[0] : -1, out_size, ws_size, (size_t)WS_END);
            grid = -1; return; }
        int dev = 0, cus = 0, per_cu = 0;
        if (hipGetDevice(&dev) != hipSuccess || hipDeviceGetAttribute(&cus, hipDeviceAttributeMultiprocessorCount, dev) != hipSuccess) { grid = -1; return; }
        if (hipFuncSetAttribute((const void*)mega_fwd, hipFuncAttributeMaxDynamicSharedMemorySize, LDS_BYTES) != hipSuccess) { fprintf(stderr, "kernel_launch: hipFuncSetAttribute failed\n"); grid = -1; return; }
        if (hipOccupancyMaxActiveBlocksPerMultiprocessor(&per_cu, (const void*)mega_fwd, NWAVES * 64, LDS_BYTES) != hipSuccess || per_cu < 1) { fprintf(stderr, "kernel_launch: occupancy query reports %d\n", per_cu); per_cu = 1; }
        (void)hipGetLastError();
        grid = cus;
        if (grid != 256) fprintf(stderr, "kernel_launch: note: %d CUs\n", grid);
    }
    if (grid < 0) return;
    Params p{};
    for (int i = 0; i < 18; ++i) p.in[i] = (const float*)d_in[i];
    p.out = (float*)d_out; p.ws = (unsigned char*)d_ws;
#if ONE_LAUNCH
    if (hipMemsetAsync((char*)d_ws + WS_CTL, 0, CTL_ZERO_BYTES, stream) != hipSuccess) { fprintf(stderr, "kernel_launch: memset failed\n"); return; }
    p.ph_lo = 0; p.ph_hi = N_PHASES; p.coop = 1; p.pad = 0;
    void* args[] = {&p};
    hipError_t e = hipLaunchCooperativeKernel((const void*)mega_fwd, dim3(grid), dim3(NWAVES * 64), args, LDS_BYTES, stream);
    if (e != hipSuccess) fprintf(stderr, "cooperative launch failed: %s (grid %d)\n", hipGetErrorString(e), grid);
#else
    for (int ph = 0; ph < N_PHASES; ++ph) {
        p.ph_lo = ph; p.ph_hi = ph + 1; p.coop = 0; p.pad = 0;
        hipLaunchKernelGGL(mega_fwd, dim3(grid), dim3(NWAVES * 64), LDS_BYTES, stream, p);
    }
#endif
}
```
